# Optimizing an MI355X kernel written in HIP

```python
import jax, jax.numpy as jnp
from jax import lax
import numpy as np

D_MODEL = 2048
BATCH = 16
SEQ = 2048
DEPTH = 1

HEAD_DIM = 128
N_FOX_HEADS = 8
N_MOBA_HEADS = 8
FOX_WIDTH = N_FOX_HEADS * HEAD_DIM
MOBA_WIDTH = N_MOBA_HEADS * HEAD_DIM
Q_BLOCK = 128
MOBA_BLOCK = 256
MOBA_TOPK = 3
ROPE_THETA = 500000.0
ROPE_DIM = HEAD_DIM // 4
N_EXPERTS = 32
TOP_K = 4
D_EXPERT = D_MODEL
SWIGLU_ALPHA = 1.702
SWIGLU_LIMIT = 7.0
MOE_ROW_BLOCK = 512
RMS_EPS = 1e-5
IN_SPLITS = [FOX_WIDTH, FOX_WIDTH, FOX_WIDTH, N_FOX_HEADS, MOBA_WIDTH, MOBA_WIDTH, MOBA_WIDTH, D_MODEL, D_MODEL]
IN_COLS = sum(IN_SPLITS)

kernel_name = "fox_moba_gated_hybrid_moe"


def rms_norm(x, g):
    xf = x.astype(jnp.float32)
    y = xf * lax.rsqrt(jnp.mean(xf * xf, axis=-1, keepdims=True) + RMS_EPS)
    return (y * g.astype(jnp.float32)).astype(x.dtype)


def partial_rotary(t, pos):
    half = ROPE_DIM // 2
    inv_freq = 1.0 / (ROPE_THETA ** (jnp.arange(half, dtype=jnp.float32) / half))
    ang = pos.astype(jnp.float32)[:, None] * inv_freq[None, :]
    cos, sin = jnp.cos(ang), jnp.sin(ang)
    tr = t[..., :ROPE_DIM].astype(jnp.float32)
    t1, t2 = tr[..., :half], tr[..., half:]
    rot = jnp.concatenate([t1 * cos - t2 * sin, t2 * cos + t1 * sin], axis=-1).astype(t.dtype)
    return jnp.concatenate([rot, t[..., ROPE_DIM:]], axis=-1)


def forgetting_attention(q, k, v, log_f):
    B, H, S, hd = q.shape
    nq = S // Q_BLOCK
    scale = hd ** -0.5
    c = jnp.cumsum(log_f, axis=-1)
    pos = jnp.arange(S)
    qb = q.reshape(B, H, nq, Q_BLOCK, hd).transpose(2, 0, 1, 3, 4)
    cb = c.reshape(B, H, nq, Q_BLOCK).transpose(2, 0, 1, 3)
    pb = pos.reshape(nq, Q_BLOCK)

    def query_block(args):
        qi, ci, pi = args
        s = jnp.einsum('bhqd,bhkd->bhqk', qi, k).astype(jnp.float32) * scale
        s = s + ci[..., None] - c[..., None, :]
        s = jnp.where(pi[:, None] >= pos[None, :], s, -jnp.inf)
        p = jax.nn.softmax(s, axis=-1).astype(v.dtype)
        return jnp.einsum('bhqk,bhkd->bhqd', p, v)

    o = lax.map(query_block, (qb, cb, pb))
    return o.transpose(1, 2, 0, 3, 4).reshape(B, H, S, hd)


def moba_attention(q, k, v):
    B, H, S, hd = q.shape
    scale = hd ** -0.5
    nblk = -(-S // MOBA_BLOCK)
    pad = ((0, 0), (0, 0), (0, nblk * MOBA_BLOCK - S), (0, 0))
    kb = jnp.pad(k, pad).reshape(B, H, nblk, MOBA_BLOCK, hd)
    vb = jnp.pad(v, pad).reshape(B, H, nblk, MOBA_BLOCK, hd)
    kmean = jnp.mean(kb.astype(jnp.float32), axis=3)
    n_sel = min(MOBA_TOPK, nblk)
    n_past = n_sel * MOBA_BLOCK
    nq = S // Q_BLOCK
    qb = q.reshape(B, H, nq, Q_BLOCK, hd).transpose(2, 0, 1, 3, 4).reshape(nq * B, H, Q_BLOCK, hd)
    blk_ids = jnp.arange(nblk)
    h_ids = jnp.arange(H)[:, None, None]

    def step(args):
        qi, n = args
        ci = n // B
        bi = n % B
        q_start = ci * Q_BLOCK
        own = q_start // MOBA_BLOCK
        qpos = q_start + jnp.arange(Q_BLOCK)
        kb_b, vb_b, km_b = kb[bi], vb[bi], kmean[bi]
        gate = jnp.einsum('hqd,hnd->hqn', qi.astype(jnp.float32), km_b)
        gate = jnp.where((blk_ids < own)[None, None, :], gate, -jnp.inf)
        _, sel = lax.top_k(gate, n_sel)
        sel_ok = sel < own
        k_sel = kb_b[h_ids, sel]
        v_sel = vb_b[h_ids, sel]
        s_past = jnp.einsum('hqd,hqnkd->hqnk', qi, k_sel).astype(jnp.float32) * scale
        s_past = jnp.where(sel_ok[..., None], s_past, -jnp.inf).reshape(H, Q_BLOCK, n_past)
        k_own = lax.dynamic_index_in_dim(kb_b, own, axis=1, keepdims=False)
        v_own = lax.dynamic_index_in_dim(vb_b, own, axis=1, keepdims=False)
        kpos = own * MOBA_BLOCK + jnp.arange(MOBA_BLOCK)
        s_own = jnp.einsum('hqd,hkd->hqk', qi, k_own).astype(jnp.float32) * scale
        s_own = jnp.where(qpos[:, None] >= kpos[None, :], s_own, -jnp.inf)
        p = jax.nn.softmax(jnp.concatenate([s_past, s_own], axis=-1), axis=-1).astype(v.dtype)
        p_past = p[..., :n_past].reshape(H, Q_BLOCK, n_sel, MOBA_BLOCK)
        return (jnp.einsum('hqnk,hqnkd->hqd', p_past, v_sel)
                + jnp.einsum('hqk,hkd->hqd', p[..., n_past:], v_own))

    o = lax.map(step, (qb, jnp.arange(nq * B)))
    return o.reshape(nq, B, H, Q_BLOCK, hd).transpose(1, 2, 0, 3, 4).reshape(B, H, S, hd)


def moe_ffn(h, w_router, b_router, w1, b1, w2, b2):
    B, S, D = h.shape
    T = B * S
    M = MOE_ROW_BLOCK
    ht = h.reshape(T, D)
    logits = (ht @ w_router).astype(jnp.float32) + b_router.astype(jnp.float32)
    top_vals, top_idx = lax.top_k(logits, TOP_K)
    gates = jax.nn.softmax(top_vals, axis=-1).astype(h.dtype)
    A = T * TOP_K
    flat_e = top_idx.reshape(A).astype(jnp.int32)
    flat_tok = jnp.arange(A, dtype=jnp.int32) // TOP_K
    flat_w = gates.reshape(A)
    order = jnp.argsort(flat_e)
    sorted_e = flat_e[order]
    counts = jnp.bincount(flat_e, length=N_EXPERTS).astype(jnp.int32)
    padded = (counts + M - 1) // M * M
    start = jnp.cumsum(counts) - counts
    pend = jnp.cumsum(padded)
    pstart = pend - padded
    dest = pstart[sorted_e] + jnp.arange(A, dtype=jnp.int32) - start[sorted_e]
    n_blocks = (A + N_EXPERTS * (M - 1) + M - 1) // M
    rows = n_blocks * M
    row_tok = jnp.full((rows,), T, jnp.int32).at[dest].set(flat_tok[order])
    row_w = jnp.zeros((rows,), h.dtype).at[dest].set(flat_w[order])
    block_e = jnp.minimum(jnp.searchsorted(pend, jnp.arange(n_blocks, dtype=jnp.int32) * M, side='right'),
                          N_EXPERTS - 1)
    h_pad = jnp.concatenate([ht, jnp.zeros((1, D), ht.dtype)], axis=0)

    def expert_block(args):
        tok, wgt, e = args
        xb = h_pad[tok]
        u = xb @ w1[e] + b1[e]
        glu = jnp.minimum(u[:, ::2], SWIGLU_LIMIT)
        lin = jnp.clip(u[:, 1::2], -SWIGLU_LIMIT, SWIGLU_LIMIT)
        a = glu * jax.nn.sigmoid(SWIGLU_ALPHA * glu) * (lin + 1.0)
        return (a @ w2[e] + b2[e]) * wgt[:, None]

    y = lax.map(expert_block, (row_tok.reshape(n_blocks, M), row_w.reshape(n_blocks, M), block_e))
    out = jax.ops.segment_sum(y.reshape(rows, D), row_tok, num_segments=T + 1)[:T]
    return out.reshape(B, S, D)


def hybrid_layer(x, norm_mix_g, w_in, b_forget, w_branch_fox, w_branch_moba, w_out, norm_ffn_g,
                 w_router, b_router, w_mlp1, b_mlp1, w_mlp2, b_mlp2):
    B, S, D = x.shape
    h = rms_norm(x, norm_mix_g)
    proj = jnp.einsum('bsd,de->bse', h, w_in)
    qf, kf, vf, fl, qm, km, vm, ga, gb = jnp.split(proj, list(np.cumsum(IN_SPLITS)[:-1]), axis=-1)

    def heads(t, n):
        return t.reshape(B, S, n, HEAD_DIM).transpose(0, 2, 1, 3)

    def merge(t):
        return t.transpose(0, 2, 1, 3).reshape(B, S, -1)

    pos = jnp.arange(S)
    log_f = jax.nn.log_sigmoid(fl.astype(jnp.float32) + b_forget.astype(jnp.float32)).transpose(0, 2, 1)
    o_fox = forgetting_attention(heads(qf, N_FOX_HEADS), heads(kf, N_FOX_HEADS), heads(vf, N_FOX_HEADS), log_f)
    o_moba = moba_attention(partial_rotary(heads(qm, N_MOBA_HEADS), pos),
                            partial_rotary(heads(km, N_MOBA_HEADS), pos),
                            heads(vm, N_MOBA_HEADS))
    y_fox = merge(o_fox) @ w_branch_fox
    y_moba = merge(o_moba) @ w_branch_moba
    mixed = jax.nn.sigmoid(ga) * y_fox + jax.nn.sigmoid(gb) * y_moba
    x = x + mixed @ w_out
    x = x + moe_ffn(rms_norm(x, norm_ffn_g), w_router, b_router, w_mlp1, b_mlp1, w_mlp2, b_mlp2)
    return x


def setup_inputs(seed: int = 0) -> dict:
    key = jax.random.key(seed)
    ks = jax.random.split(key, 16)
    f32 = jnp.float32

    def nrm(k, shape, scale):
        return jax.random.normal(k, shape, f32) * scale

    return {
        'x': nrm(ks[0], (BATCH, SEQ, D_MODEL), 1.0),
        'norm_mix_g': 1.0 + nrm(ks[1], (DEPTH, D_MODEL), 0.02),
        'w_in': nrm(ks[2], (DEPTH, D_MODEL, IN_COLS), D_MODEL ** -0.5),
        'b_forget': jax.random.uniform(ks[3], (DEPTH, N_FOX_HEADS), f32, 1.0, 4.0),
        'w_branch_fox': nrm(ks[4], (DEPTH, FOX_WIDTH, D_MODEL), FOX_WIDTH ** -0.5),
        'w_branch_moba': nrm(ks[5], (DEPTH, MOBA_WIDTH, D_MODEL), MOBA_WIDTH ** -0.5),
        'w_out': nrm(ks[6], (DEPTH, D_MODEL, D_MODEL), D_MODEL ** -0.5),
        'norm_ffn_g': 1.0 + nrm(ks[7], (DEPTH, D_MODEL), 0.02),
        'w_router': nrm(ks[8], (DEPTH, D_MODEL, N_EXPERTS), D_MODEL ** -0.5),
        'b_router': nrm(ks[9], (DEPTH, N_EXPERTS), 0.01),
        'w_mlp1': nrm(ks[10], (DEPTH, N_EXPERTS, D_MODEL, 2 * D_EXPERT), D_MODEL ** -0.5),
        'b_mlp1': nrm(ks[11], (DEPTH, N_EXPERTS, 2 * D_EXPERT), 0.02),
        'w_mlp2': nrm(ks[12], (DEPTH, N_EXPERTS, D_EXPERT, D_MODEL), D_EXPERT ** -0.5),
        'b_mlp2': nrm(ks[13], (DEPTH, N_EXPERTS, D_MODEL), 0.02),
        'norm_final_g': 1.0 + nrm(ks[14], (D_MODEL,), 0.02),
    }


def reference(x, norm_mix_g, w_in, b_forget, w_branch_fox, w_branch_moba, w_out, norm_ffn_g,
              w_router, b_router, w_mlp1, b_mlp1, w_mlp2, b_mlp2, norm_final_g):
    for l in range(DEPTH):
        x = hybrid_layer(x, norm_mix_g[l], w_in[l], b_forget[l], w_branch_fox[l], w_branch_moba[l], w_out[l],
                         norm_ffn_g[l], w_router[l], b_router[l], w_mlp1[l], b_mlp1[l], w_mlp2[l], b_mlp2[l])
    return rms_norm(x, norm_final_g)
```

```cpp
#include <hip/hip_runtime.h>
#include <cstdio>
#include <cstdint>

#ifndef REPEAT_MASK
#define REPEAT_MASK 0
#endif
#define REP(k) ((REPEAT_MASK >> (k)) & 1)
#ifndef MK_PER_PHASE
#define MK_PER_PHASE 0
#endif

#define GAS __attribute__((address_space(1)))
#define LAS __attribute__((address_space(3)))
typedef unsigned short bf16;
typedef short bf16x8 __attribute__((ext_vector_type(8)));
typedef short s16x4 __attribute__((ext_vector_type(4)));
typedef float f32x2 __attribute__((ext_vector_type(2)));
typedef float f32x4 __attribute__((ext_vector_type(4)));
typedef float f32x16 __attribute__((ext_vector_type(16)));
typedef unsigned u32x2 __attribute__((ext_vector_type(2)));
typedef unsigned u32x4 __attribute__((ext_vector_type(4)));
typedef GAS unsigned gu32;

constexpr int NB = 16, SEQ = 2048, DM = 2048, T = NB * SEQ;
constexpr int NH = 8, HD = 128, BW = NH * HD;
constexpr int IN_COLS = 10248, FL_COL = 3072;
constexpr int NV_IN = 10240;
constexpr int NE = 32, TOPK = 4, DFF = 2048;
constexpr int ROWS_MAX = T * TOPK + NE * 256;
constexpr float RMS_EPS = 1e-5f;
constexpr float SW_ALPHA = 1.702f, SW_LIMIT = 7.0f;
constexpr float W8_SCALE = 64.0f, ACT8_SCALE = 4.0f, Y8_SCALE = 32.0f, MIX8_SCALE = 64.0f, O8_SCALE = 16.0f;

constexpr size_t MiB = 1u << 20;
constexpr size_t WS_CTL = 0, CTL_ZERO_BYTES = 1 * MiB;
constexpr size_t WS_WIN = 1 * MiB;
constexpr size_t WS_WFOX = WS_WIN + 40 * MiB;
constexpr size_t WS_WMOBA = WS_WFOX + 4 * MiB;
constexpr size_t WS_WOUT = WS_WMOBA + 4 * MiB;
constexpr size_t WS_W1 = WS_WOUT + 8 * MiB;
constexpr size_t WS_W2 = WS_W1 + 512 * MiB;
constexpr size_t WS_WR = WS_W2 + 256 * MiB;
constexpr size_t WS_ROPE = WS_WR + 1 * MiB;
constexpr size_t WS_LOGF = WS_ROPE + 1 * MiB;
constexpr size_t WS_BIAS = WS_LOGF + 1 * MiB;
constexpr size_t WS_KMEAN = WS_BIAS + 1 * MiB;
constexpr size_t WS_SELB = WS_KMEAN + 1 * MiB;
constexpr size_t WS_EIDX = WS_SELB + 1 * MiB;
constexpr size_t WS_EW = WS_EIDX + 512 * 1024;
constexpr size_t WS_RANK = WS_EW + 512 * 1024;
constexpr size_t WS_POS = WS_RANK + 512 * 1024;
constexpr size_t WS_RSTD = WS_POS + 512 * 1024;
constexpr size_t WS_ROWW = WS_RSTD + 1 * MiB;
constexpr size_t WS_H = WS_ROWW + 1 * MiB;
constexpr size_t WS_QKV = WS_H + 128 * MiB;
constexpr size_t QKV_STRIDE = (size_t)T * BW;
constexpr size_t WS_SG = WS_QKV + 384 * MiB;
constexpr size_t WS_O = WS_SG + 256 * MiB;
constexpr size_t WS_MIX = WS_O + 128 * MiB;
constexpr size_t WS_X2 = WS_MIX + 128 * MiB;
constexpr size_t WS_AS = WS_X2 + 256 * MiB;
constexpr size_t WS_ACT = WS_AS + 544 * MiB;
constexpr size_t WS_Y = WS_ACT + 544 * MiB;
constexpr size_t WS_END = WS_Y + 544 * MiB;
static_assert((size_t)ROWS_MAX * DM * 2 <= 544 * MiB, "row buffers");
constexpr int CW_TMO = 0, CW_CODE = 1;
constexpr int CW_BAR = 4096;
constexpr int CW_CNT = 8192;
constexpr int CW_P2DONE = 11264;
constexpr int CW_ATTQ = 12288;
constexpr int CONV_PER8 = 2;
constexpr int CW_ZERO = 16384;

constexpr int RING_BYTES = 131072;
constexpr int LDSCTL_OFF = RING_BYTES, MISC_OFF = LDSCTL_OFF + 320;
constexpr int TAB_OFF = LDSCTL_OFF + 1024;
constexpr int LDS_BYTES = 147456;
constexpr int NWAVES = 8;

#define RLX_AGENT __ATOMIC_RELAXED, __HIP_MEMORY_SCOPE_AGENT
#define LDS_WAIT() asm volatile("s_waitcnt lgkmcnt(0)" ::: "memory")
#define VM_WAIT() asm volatile("s_waitcnt vmcnt(0)" ::: "memory")
__device__ __forceinline__ unsigned f2bf(float f) { unsigned u = __builtin_bit_cast(unsigned, f); return (u + 0x7fffu + ((u >> 16) & 1u)) >> 16; }
__device__ __forceinline__ unsigned pk2(float lo, float hi) { return f2bf(lo) | (f2bf(hi) << 16); }
__device__ __forceinline__ float bflo(unsigned w) { return __builtin_bit_cast(float, w << 16); }
__device__ __forceinline__ float bfhi(unsigned w) { return __builtin_bit_cast(float, w & 0xffff0000u); }
typedef __bf16 bf16x2_t __attribute__((ext_vector_type(2)));
__device__ __forceinline__ unsigned cvt_pk_bf16(float lo, float hi) { f32x2 v = {lo, hi}; bf16x2_t b = __builtin_convertvector(v, bf16x2_t); return __builtin_bit_cast(unsigned, b); }
__device__ __forceinline__ unsigned pk4_fp8(float a, float b, float c, float d) { unsigned w = 0; w = __builtin_amdgcn_cvt_pk_fp8_f32(a, b, w, false); w = __builtin_amdgcn_cvt_pk_fp8_f32(c, d, w, true); return w; }
__device__ __forceinline__ int lane_now() { return (int)__builtin_amdgcn_mbcnt_hi(~0u, __builtin_amdgcn_mbcnt_lo(~0u, 0u)); }
__device__ __forceinline__ float sat8(float v) { return __builtin_amdgcn_fmed3f(v, -448.0f, 448.0f); }
__device__ __forceinline__ float wave_sum(float v) {
#pragma unroll
    for (int o = 1; o < 64; o <<= 1) v += __shfl_xor(v, o);
    return v;
}
__device__ __forceinline__ float sigmoidf_fast(float z) { return __builtin_amdgcn_rcpf(1.0f + __builtin_amdgcn_exp2f(-1.4426950408889634f * z)); }

namespace pg8 {
constexpr int BM = 256, BK = 64, HALF = 128, HTB = HALF * BK * 2, STAGE_BYTES = 8 * HTB, NXCD = 8, WGM = 4;
__host__ __device__ __forceinline__ int lds_byte(int r, int c) { const int st = (r >> 4) * 2 + (c >> 5), rr = r & 15, cc = c & 31, ob = rr * 64 + cc * 2; return st * 1024 + (ob ^ (((ob >> 9) & 1) << 5)); }
__host__ __device__ __forceinline__ void stage_rc(int b, int& R, int& C) { const int st = b / 1024, sb = b % 1024, swz = sb ^ (((sb >> 9) & 1) << 5); R = (st >> 1) * 16 + swz / 64; C = (st & 1) * 32 + (swz % 64) / 2; }
__host__ __device__ __forceinline__ int perm32(int rho) { const int n = rho >> 4, i = rho & 15; return 8 * (i >> 2) + 4 * n + (i & 3); }
__host__ __device__ __forceinline__ int perm256(int R) { return 64 * (R >> 5) + 16 * ((R & 15) >> 2) + 4 * ((R >> 4) & 1) + (R & 3); }

struct Unit { int pm, pn, e; };
struct Gemm { int KB, ldaB, ldbB; };

struct DenseOrder {
    static constexpr bool GATHER = false;
    __device__ __forceinline__ int row_src(const Unit&, int) const { return 0; }
    const bf16* A; const bf16* Bt; int lda, ldb;
    int nM, nN, nwg, G, c; int abytes, bbytes; int rep = 1;
    __device__ __forceinline__ void init(const void* A_, const void* Bt_, int lda_, int ldb_, int M, int N, int G_, int c_, int elt = 2) { A = (const bf16*)A_; Bt = (const bf16*)Bt_; lda = lda_ * elt; ldb = ldb_ * elt; nM = M / BM; nN = N / BM; nwg = nM * nN; G = G_; c = c_;
        abytes = M * lda; bbytes = N * ldb; }
    __device__ __forceinline__ bool next(int i, Unit& u) const {
        long L = (long)i * G + c; if (L >= (long)nwg * rep) return false;
        if (L >= nwg) L -= nwg;
        int wgid = (int)L; { const int q = nwg / NXCD, r = nwg % NXCD, xcd = wgid % NXCD, off = wgid / NXCD; wgid = (xcd < r ? xcd * (q + 1) : r * (q + 1) + (xcd - r) * q) + off; }
        const int nig = WGM * nN, gid = wgid / nig, fm = gid * WGM, gsz = (nM - fm) < WGM ? (nM - fm) : WGM;
        u.pm = fm + ((wgid % nig) % gsz); u.pn = (wgid % nig) / gsz; u.e = 0; return true;
    }
    __device__ __forceinline__ const void* a_base() const { return A; }
    __device__ __forceinline__ const void* b_base() const { return Bt; }
    __device__ __forceinline__ int a_bytes() const { return abytes; }
    __device__ __forceinline__ int b_bytes() const { return bbytes; }
    __device__ __forceinline__ unsigned a_off(const Unit& u) const { return (unsigned)u.pm * (unsigned)(BM * lda); }
    __device__ __forceinline__ unsigned b_off(const Unit& u) const { return (unsigned)u.pn * (unsigned)(BM * ldb); }
    __device__ __forceinline__ void a_ready(const Unit&) const {}
    __device__ __forceinline__ void done(const Unit&) const {}
};
template <int NCT, bool GATH = false> struct MoeOrder {
    static constexpr bool GATHER = GATH;
    const unsigned char* A; const unsigned char* Bt; int lda, ldb; const LAS int* tab; int G, c; int rep; const int* rowtok;
    __device__ __forceinline__ int row_src(const Unit& u, int r) const { return rowtok[u.pm * BM + r]; }
    __device__ __forceinline__ bool next(int i, Unit& u) const {
        int L = i * G + c; const int total = tab[NE] * NCT; if (L >= total * rep) return false; if (L >= total) L -= total;
        int e = 0;
#pragma unroll 1
        for (int s = 16; s >= 1; s >>= 1) { if (tab[e + s] * NCT <= L) e += s; }
        const int j = L - tab[e] * NCT, x = j & 7, qq = j >> 3;
        int rt, ct; const int nt = tab[e + 1] - tab[e];
        if (NCT == 16) { const int g8 = nt >> 3;
            if (qq < 16 * g8) { const int g = qq >> 4, q2 = qq & 15; rt = 8 * g + 4 * (x >> 2) + (q2 >> 2); ct = 4 * (x & 3) + (q2 & 3); }
            else { const int lr = qq - 16 * g8; rt = 8 * g8 + (lr >> 1); ct = 2 * x + (lr & 1); } }
        else { const int g4 = nt >> 2;
            if (qq < 4 * g4) { const int g = qq >> 2, q2 = qq & 3; rt = 4 * g + 2 * (x >> 2) + (q2 >> 1); ct = 2 * (x & 3) + (q2 & 1); }
            else { const int lr = qq - 4 * g4; rt = 4 * g4 + lr; ct = x; } }
        u.pm = tab[e] + rt; u.pn = ct; u.e = e; return true;
    }
    __device__ __forceinline__ const void* a_base() const { return A; }
    __device__ __forceinline__ const void* b_base() const { return Bt; }
    __device__ __forceinline__ int a_bytes() const { return (GATH ? T : ROWS_MAX) * lda; }
    __device__ __forceinline__ int b_bytes() const { return NE * NCT * BM * ldb; }
    __device__ __forceinline__ unsigned a_off(const Unit& u) const { return GATH ? 0u : (unsigned)u.pm * (unsigned)(BM * lda); }
    __device__ __forceinline__ unsigned b_off(const Unit& u) const { return (unsigned)(u.e * NCT + u.pn) * (unsigned)(BM * ldb); }
    __device__ __forceinline__ void a_ready(const Unit&) const {}
    __device__ __forceinline__ void done(const Unit&) const {}
};

typedef int i32x4 __attribute__((ext_vector_type(4)));
typedef int i32x8 __attribute__((ext_vector_type(8)));
__device__ __forceinline__ i32x8 cat8(bf16x8 a, bf16x8 b) { const i32x4 x = __builtin_bit_cast(i32x4, a), y = __builtin_bit_cast(i32x4, b); return __builtin_shufflevector(x, y, 0, 1, 2, 3, 4, 5, 6, 7); }
template <class Epi, class Sched, bool ALIGN_EPI, bool SP2, bool FP8 = false>
__device__ __forceinline__ void gemm_phase(LAS unsigned char* lds, const Gemm g, const Sched& S, const Epi& E, int wave) {
    const int wid = wave, lane = lane_now(), tid = wid * 64 + lane, wr = wid >> 2, wc = wid & 3, fr = lane & 15, fq = lane >> 4;
    const int nt = g.KB / (BK * 2);
    unsigned voffA[2][2], voffN[2][2], voffB[2], voffS[2];
#pragma unroll
    for (int i = 0; i < 2; ++i) { int R, C; stage_rc(tid * 16 + i * 8192, R, C); const int Rb = Epi::PERM ? perm256(R) : R;
        voffS[i] = (unsigned)(R * g.ldaB + C * 2); voffB[i] = (unsigned)(Rb * g.ldbB + C * 2); }
#define PG8_VOFF(dst, u) do { if constexpr (Sched::GATHER) { int t_ = lane_now(); asm volatile("" : "+v"(t_)); t_ += wid * 64;        \
        _Pragma("unroll") for (int i_ = 0; i_ < 2; ++i_) { int R_, C_; stage_rc(t_ * 16 + i_ * 8192, R_, C_); \
        _Pragma("unroll") for (int h_ = 0; h_ < 2; ++h_) dst[h_][i_] = (unsigned)S.row_src(u, h_ * HALF + R_) * (unsigned)g.ldaB + (unsigned)(C_ * 2); } } } while (0)
    const unsigned kstep = (unsigned)(BK * 2);
    const unsigned hstepA = Sched::GATHER ? 0u : (unsigned)(HALF * g.ldaB), hstepB = (unsigned)((Epi::PERM ? 8 : HALF) * g.ldbB);
    const __amdgpu_buffer_rsrc_t rsA = __builtin_amdgcn_make_buffer_rsrc((void*)S.a_base(), (short)0, S.a_bytes(), 0x00020000);
    const __amdgpu_buffer_rsrc_t rsB = __builtin_amdgcn_make_buffer_rsrc((void*)S.b_base(), (short)0, S.b_bytes(), 0x00020000);
    const unsigned ldsw = (unsigned)wid * 1024u;
    const int aoff = lds_byte(wr * 64 + fr, fq * 8); int boff = lds_byte(wc * 32 + fr, fq * 8) + 4 * HTB;
    asm volatile("" : "+v"(boff));
#define PG8_SA(b, h) (((b) * 2 + (h)) * HTB)
#define PG8_SB(b, h) ((4 + (b) * 2 + (h)) * HTB)
#define PG8_STAGEX(bufoff, rs, soff, voff) do { _Pragma("unroll") for (int _i = 0; _i < 2; ++_i) \
        __builtin_amdgcn_raw_ptr_buffer_load_lds(rs, (LAS unsigned*)(lds + (bufoff) + ldsw + _i * 8192), 16, (voff)[_i], (soff), 0, 0); } while (0)
#define PG8_STAGE(bufoff, gbase, voff) PG8_STAGE_##voff(bufoff, gbase)
#define PG8_STAGE_voffA(bufoff, soff) do { if constexpr (Sched::GATHER) PG8_STAGEX(bufoff, rsA, soff, voffA[((bufoff) / HTB) & 1]); else PG8_STAGEX(bufoff, rsA, soff, voffS); } while (0)
#define PG8_STAGE_voffX(bufoff, soff) do { if constexpr (Sched::GATHER) { const unsigned vx_[2] = {lastx ? voffN[((bufoff) / HTB) & 1][0] : voffA[((bufoff) / HTB) & 1][0], lastx ? voffN[((bufoff) / HTB) & 1][1] : voffA[((bufoff) / HTB) & 1][1]}; \
        PG8_STAGEX(bufoff, rsA, soff, vx_); } else PG8_STAGEX(bufoff, rsA, soff, voffS); } while (0)
#define PG8_STAGE_voffB(bufoff, soff) PG8_STAGEX(bufoff, rsB, soff, voffB)
#define PG8_LD8(off) __builtin_shufflevector(*(const LAS i32x4*)(lds + (off)), *(const LAS i32x4*)(lds + (off) + 1024), 0, 1, 2, 3, 4, 5, 6, 7)
#define PG8_LDA(dst, b, h) do { _Pragma("unroll") for (int m = 0; m < 4; ++m) { if constexpr (FP8) dst##8[m] = PG8_LD8(PG8_SA(b, h) + aoff + m * 2048); \
        else { _Pragma("unroll") for (int k = 0; k < 2; ++k) dst[m][k] = *(const LAS bf16x8*)(lds + PG8_SA(b, h) + aoff + m * 2048 + k * 1024); } } } while (0)
#define PG8_SBR(b, h) (((b) * 2 + (h)) * HTB)
#define PG8_LDB(dst, b, h) do { _Pragma("unroll") for (int n = 0; n < 2; ++n) { if constexpr (FP8) dst##8[n] = PG8_LD8(PG8_SBR(b, h) + boff + n * 2048); \
        else { _Pragma("unroll") for (int k = 0; k < 2; ++k) dst[n][k] = *(const LAS bf16x8*)(lds + PG8_SBR(b, h) + boff + n * 2048 + k * 1024); } } } while (0)
#define PG8_MMA(ai, bj, At, Bt) do { __builtin_amdgcn_s_setprio(1); _Pragma("unroll") for (int m = 0; m < 4; ++m) _Pragma("unroll") for (int n = 0; n < 2; ++n) { \
        if constexpr (FP8) acc[ai][bj][m][n] = __builtin_amdgcn_mfma_scale_f32_16x16x128_f8f6f4(Bt##8[n], At##8[m], acc[ai][bj][m][n], 0, 0, 0, 0, 0, 0); \
        else { _Pragma("unroll") for (int k = 0; k < 2; ++k) acc[ai][bj][m][n] = __builtin_amdgcn_mfma_f32_16x16x32_bf16(Bt[n][k], At[m][k], acc[ai][bj][m][n], 0, 0, 0); } } \
        __builtin_amdgcn_s_setprio(0); } while (0)
#define PG8_WAIT_V(n) asm volatile("s_waitcnt vmcnt(" #n ")" ::: "memory")
#define PG8_WAIT_L(n) asm volatile("s_waitcnt lgkmcnt(" #n ")" ::: "memory")
#define PG8_BAR __builtin_amdgcn_s_barrier()
#define PG8_SCHED __builtin_amdgcn_sched_barrier(0)
    Unit cur, nxt; int ui = 0;
    if (!S.next(0, cur)) return;
    f32x4 acc[2][2][4][2];
#pragma unroll
    for (int a = 0; a < 2; ++a)
#pragma unroll
        for (int b = 0; b < 2; ++b)
#pragma unroll
            for (int m = 0; m < 4; ++m)
#pragma unroll
                for (int n = 0; n < 2; ++n) acc[a][b][m][n] = (f32x4){0.f, 0.f, 0.f, 0.f};
    bf16x8 At[4][2], B0[2][2], B1[2][2]; i32x8 At8[4], B08[2], B18[2];
    unsigned cA = S.a_off(cur), cB = S.b_off(cur);
    PG8_VOFF(voffA, cur);
    S.a_ready(cur);
    if constexpr (SP2) {
        PG8_STAGE(PG8_SB(0, 0), cB, voffB); PG8_STAGE(PG8_SB(0, 1), cB + hstepB, voffB); PG8_STAGE(PG8_SA(0, 0), cA, voffA); PG8_STAGE(PG8_SA(0, 1), cA + hstepA, voffA);
        if (wr == 1) PG8_BAR;
        PG8_WAIT_V(2); PG8_BAR;
        PG8_STAGE(PG8_SB(1, 0), cB + kstep, voffB); PG8_STAGE(PG8_SA(1, 0), cA + kstep, voffA); PG8_STAGE(PG8_SB(1, 1), cB + hstepB + kstep, voffB);
        PG8_WAIT_V(6); PG8_BAR;
    } else {
        PG8_STAGE(PG8_SB(0, 0), cB, voffB); PG8_STAGE(PG8_SA(0, 0), cA, voffA); PG8_STAGE(PG8_SB(0, 1), cB + hstepB, voffB); PG8_STAGE(PG8_SA(0, 1), cA + hstepA, voffA);
        if (wr == 1) PG8_BAR;
        PG8_WAIT_V(4); PG8_BAR;
        PG8_STAGE(PG8_SB(1, 0), cB + kstep, voffB); PG8_STAGE(PG8_SA(1, 0), cA + kstep, voffA); PG8_STAGE(PG8_SB(1, 1), cB + hstepB + kstep, voffB);
        PG8_WAIT_V(6); PG8_BAR;
    }
    for (;;) {
        const bool has_next = S.next(ui + 1, nxt);
        const unsigned nA = has_next ? S.a_off(nxt) : cA, nB = has_next ? S.b_off(nxt) : cB;
        if constexpr (Sched::GATHER) { if (has_next) PG8_VOFF(voffN, nxt); else {
#pragma unroll
            for (int h_ = 0; h_ < 2; ++h_) { voffN[h_][0] = voffA[h_][0]; voffN[h_][1] = voffA[h_][1]; } } }
#pragma unroll 1
        for (int t = 0; t < nt; t += 2) {
            const bool last = (t == nt - 2);
            const bool lastx = last;
            const unsigned a1 = cA + (unsigned)(t + 1) * kstep;
            const unsigned a2 = last ? nA : cA + (unsigned)(t + 2) * kstep, b2 = last ? nB : cB + (unsigned)(t + 2) * kstep;
            const unsigned a3 = a2 + kstep, b3 = b2 + kstep;
            if (last && has_next) S.a_ready(nxt);
            if constexpr (Epi::HAS_MID) { if (t == nt / 2) { int lm_ = lane_now(); asm volatile("" : "+v"(lm_)); E.mid(acc, cur, wr, wc, lm_ & 15, lm_ >> 4); } }
            if constexpr (SP2) {
            PG8_LDB(B0, 0, 0); PG8_LDB(B1, 0, 1); PG8_SCHED; PG8_LDA(At, 0, 0); PG8_STAGE(PG8_SA(1, 1), a1 + hstepA, voffA);
            PG8_WAIT_V(8); PG8_WAIT_L(0); PG8_BAR; PG8_MMA(0, 0, At, B0); PG8_MMA(0, 1, At, B1); PG8_BAR; PG8_SCHED;
            PG8_LDA(At, 0, 1); PG8_STAGE(PG8_SB(0, 0), b2, voffB); PG8_STAGE(PG8_SB(0, 1), b2 + hstepB, voffB); PG8_STAGE(PG8_SA(0, 0), a2, voffX);
            PG8_WAIT_V(8); PG8_WAIT_L(0); PG8_BAR; PG8_MMA(1, 0, At, B0); PG8_MMA(1, 1, At, B1); PG8_BAR; PG8_SCHED;
            PG8_LDB(B0, 1, 0); PG8_LDB(B1, 1, 1); PG8_SCHED; PG8_LDA(At, 1, 0); PG8_STAGE(PG8_SA(0, 1), a2 + hstepA, voffX);
            PG8_WAIT_V(8); PG8_WAIT_L(0); PG8_BAR; PG8_MMA(0, 0, At, B0); PG8_MMA(0, 1, At, B1); PG8_BAR; PG8_SCHED;
            PG8_LDA(At, 1, 1); PG8_STAGE(PG8_SB(1, 0), b3, voffB); PG8_STAGE(PG8_SB(1, 1), b3 + hstepB, voffB); PG8_STAGE(PG8_SA(1, 0), a3, voffX);
            PG8_WAIT_V(8); PG8_WAIT_L(0); PG8_BAR; PG8_MMA(1, 0, At, B0); PG8_MMA(1, 1, At, B1); PG8_BAR; PG8_SCHED;
            } else {
            PG8_LDB(B0, 0, 0); PG8_SCHED; PG8_LDA(At, 0, 0); PG8_STAGE(PG8_SA(1, 1), a1 + hstepA, voffA);
            PG8_WAIT_L(8); PG8_BAR; PG8_WAIT_L(0); PG8_MMA(0, 0, At, B0); PG8_BAR; PG8_SCHED;
            PG8_LDB(B1, 0, 1); PG8_STAGE(PG8_SB(0, 0), b2, voffB);
            PG8_BAR; PG8_WAIT_L(0); PG8_MMA(0, 1, At, B1); PG8_BAR;
            PG8_LDA(At, 0, 1); PG8_STAGE(PG8_SA(0, 0), a2, voffX);
            PG8_BAR; PG8_WAIT_L(0); PG8_MMA(1, 0, At, B0); PG8_BAR; PG8_SCHED;
            PG8_STAGE(PG8_SB(0, 1), b2 + hstepB, voffB);
            PG8_WAIT_V(6); PG8_BAR; PG8_MMA(1, 1, At, B1); PG8_BAR;
            PG8_LDB(B0, 1, 0); PG8_SCHED; PG8_LDA(At, 1, 0); PG8_STAGE(PG8_SA(0, 1), a2 + hstepA, voffX);
            PG8_WAIT_L(8); PG8_BAR; PG8_WAIT_L(0); PG8_MMA(0, 0, At, B0); PG8_BAR; PG8_SCHED;
            PG8_LDB(B1, 1, 1); PG8_STAGE(PG8_SB(1, 0), b3, voffB);
            PG8_BAR; PG8_WAIT_L(0); PG8_MMA(0, 1, At, B1); PG8_BAR;
            PG8_LDA(At, 1, 1); PG8_STAGE(PG8_SA(1, 0), a3, voffX);
            PG8_BAR; PG8_WAIT_L(0); PG8_MMA(1, 0, At, B0); PG8_BAR; PG8_SCHED;
            PG8_STAGE(PG8_SB(1, 1), b3 + hstepB, voffB);
            PG8_WAIT_V(6); PG8_BAR; PG8_MMA(1, 1, At, B1); PG8_BAR;
            }
        }
        if constexpr (ALIGN_EPI) { if (wr == 0) PG8_BAR; }
        { int le_ = lane_now(); asm volatile("" : "+v"(le_));
          E(acc, cur, wr, wc, le_ & 15, le_ >> 4); } S.done(cur);
        if (!has_next) break;
#pragma unroll
        for (int a = 0; a < 2; ++a)
#pragma unroll
            for (int b = 0; b < 2; ++b)
#pragma unroll
                for (int m = 0; m < 4; ++m)
#pragma unroll
                    for (int n = 0; n < 2; ++n) acc[a][b][m][n] = (f32x4){0.f, 0.f, 0.f, 0.f};
        cur = nxt; cA = nA; cB = nB; ++ui;
        if constexpr (Sched::GATHER) {
#pragma unroll
            for (int h_ = 0; h_ < 2; ++h_) { voffA[h_][0] = voffN[h_][0]; voffA[h_][1] = voffN[h_][1]; } }
        if constexpr (ALIGN_EPI) { if (wr == 1) PG8_BAR; }
    }
    PG8_WAIT_V(0);
    if constexpr (!ALIGN_EPI) { if (wr == 0) PG8_BAR; }
    PG8_BAR;
#undef PG8_SA
#undef PG8_SB
#undef PG8_SBR
#undef PG8_STAGE
#undef PG8_STAGEX
#undef PG8_STAGE_voffA
#undef PG8_STAGE_voffX
#undef PG8_VOFF
#undef PG8_STAGE_voffB
#undef PG8_LDA
#undef PG8_LD8
#undef PG8_LDB
#undef PG8_MMA
#undef PG8_WAIT_V
#undef PG8_WAIT_L
#undef PG8_BAR
#undef PG8_SCHED
}

struct EpiInProj {
    static constexpr bool PERM = true, HAS_MID = false;
    bf16* QKV; bf16* SG;
    static constexpr float DS = 1.0f / W8_SCALE;
    __device__ __forceinline__ void operator()(const f32x4 (&acc)[2][2][4][2], const Unit& u, int wr, int wc, int fr, int fq) const {
        const int row0 = u.pm * BM + wr * 64 + fr;
        if (u.pn < 24) {
            const int t = u.pn >> 2; bf16* base = QKV + (size_t)t * QKV_STRIDE; const int col0 = (u.pn & 3) * BM + wc * 64 + 16 * fq;
#pragma unroll
            for (int ai = 0; ai < 2; ++ai)
#pragma unroll
                for (int m = 0; m < 4; ++m) { const int row = row0 + ai * HALF + m * 16; bf16* rowp = base + (size_t)row * BW + col0;
#pragma unroll
                    for (int bj = 0; bj < 2; ++bj) { const f32x4 v0 = acc[ai][bj][m][0] * DS, v1 = acc[ai][bj][m][1] * DS;
                        u32x4 w; w.x = cvt_pk_bf16(v0[0], v0[1]); w.y = cvt_pk_bf16(v0[2], v0[3]); w.z = cvt_pk_bf16(v1[0], v1[1]); w.w = cvt_pk_bf16(v1[2], v1[3]);
                        *(u32x4*)(rowp + bj * 8) = w; } }
        } else {
            const int col0 = (u.pn - 24) * BM + wc * 64 + 16 * fq;
#pragma unroll
            for (int ai = 0; ai < 2; ++ai)
#pragma unroll
                for (int m = 0; m < 4; ++m) { const int row = row0 + ai * HALF + m * 16; bf16* rowp = SG + (size_t)row * 4096 + col0;
#pragma unroll
                    for (int bj = 0; bj < 2; ++bj) {
                        const f32x4 e0 = acc[ai][bj][m][0] * (-DS * 1.4426950408889634f), e1 = acc[ai][bj][m][1] * (-DS * 1.4426950408889634f);
                        const f32x4 d0 = (f32x4){__builtin_amdgcn_exp2f(e0[0]), __builtin_amdgcn_exp2f(e0[1]), __builtin_amdgcn_exp2f(e0[2]), __builtin_amdgcn_exp2f(e0[3])} + 1.0f;
                        const f32x4 d1 = (f32x4){__builtin_amdgcn_exp2f(e1[0]), __builtin_amdgcn_exp2f(e1[1]), __builtin_amdgcn_exp2f(e1[2]), __builtin_amdgcn_exp2f(e1[3])} + 1.0f;
                        u32x4 w; w.x = cvt_pk_bf16(__builtin_amdgcn_rcpf(d0[0]), __builtin_amdgcn_rcpf(d0[1])); w.y = cvt_pk_bf16(__builtin_amdgcn_rcpf(d0[2]), __builtin_amdgcn_rcpf(d0[3]));
                        w.z = cvt_pk_bf16(__builtin_amdgcn_rcpf(d1[0]), __builtin_amdgcn_rcpf(d1[1])); w.w = cvt_pk_bf16(__builtin_amdgcn_rcpf(d1[2]), __builtin_amdgcn_rcpf(d1[3]));
                        *(u32x4*)(rowp + bj * 8) = w; }
                    asm volatile("" ::: "memory"); }
        }
    }
};
struct EpiGate {
    static constexpr bool PERM = true, HAS_MID = true;
    const bf16* SG; unsigned char* MIX8;
    __device__ __forceinline__ void mid(f32x4 (&acc)[2][2][4][2], const Unit& u, int wr, int wc, int fr, int fq) const {
        const int row0 = u.pm * BM + wr * 64 + fr, col0 = u.pn * BM + wc * 64 + 16 * fq;
#pragma unroll
        for (int ai = 0; ai < 2; ++ai)
#pragma unroll
        for (int mh = 0; mh < 2; ++mh) { u32x4 ga[2][2], gb[2][2];
#pragma unroll
            for (int mm = 0; mm < 2; ++mm) { const int row = row0 + ai * HALF + (2 * mh + mm) * 16;
#pragma unroll
                for (int bj = 0; bj < 2; ++bj) { ga[mm][bj] = *(const u32x4*)(SG + (size_t)row * 4096 + col0 + bj * 8); gb[mm][bj] = *(const u32x4*)(SG + (size_t)row * 4096 + DM + col0 + bj * 8); } }
#pragma unroll
            for (int mm = 0; mm < 2; ++mm) { const int m = 2 * mh + mm;
#pragma unroll
                for (int bj = 0; bj < 2; ++bj) { const u32x4 a = ga[mm][bj], b = gb[mm][bj];
                    const f32x4 r0 = {bflo(a.x) * __builtin_amdgcn_rcpf(bflo(b.x)), bfhi(a.x) * __builtin_amdgcn_rcpf(bfhi(b.x)), bflo(a.y) * __builtin_amdgcn_rcpf(bflo(b.y)), bfhi(a.y) * __builtin_amdgcn_rcpf(bfhi(b.y))};
                    const f32x4 r1 = {bflo(a.z) * __builtin_amdgcn_rcpf(bflo(b.z)), bfhi(a.z) * __builtin_amdgcn_rcpf(bfhi(b.z)), bflo(a.w) * __builtin_amdgcn_rcpf(bflo(b.w)), bfhi(a.w) * __builtin_amdgcn_rcpf(bfhi(b.w))};
                    acc[ai][bj][m][0] = acc[ai][bj][m][0] * r0; acc[ai][bj][m][1] = acc[ai][bj][m][1] * r1; } }
            asm volatile("" ::: "memory"); }
    }
    __device__ __forceinline__ void operator()(const f32x4 (&acc)[2][2][4][2], const Unit& u, int wr, int wc, int fr, int fq) const {
        const int row0 = u.pm * BM + wr * 64 + fr, col0 = u.pn * BM + wc * 64 + 16 * fq;
#pragma unroll
        for (int ai = 0; ai < 2; ++ai)
#pragma unroll
        for (int mh = 0; mh < 2; ++mh) { u32x4 gb[2][2];
#pragma unroll
            for (int mm = 0; mm < 2; ++mm) { const int row = row0 + ai * HALF + (2 * mh + mm) * 16;
#pragma unroll
                for (int bj = 0; bj < 2; ++bj) gb[mm][bj] = *(const u32x4*)(SG + (size_t)row * 4096 + DM + col0 + bj * 8); }
#pragma unroll
            for (int mm = 0; mm < 2; ++mm) { const int m = 2 * mh + mm; const int row = row0 + ai * HALF + m * 16;
                u32x4 w4;
#pragma unroll
                for (int bj = 0; bj < 2; ++bj) { constexpr float DS = MIX8_SCALE / (W8_SCALE * O8_SCALE); const u32x4 g = gb[mm][bj]; f32x4 v0 = acc[ai][bj][m][0] * DS, v1 = acc[ai][bj][m][1] * DS;
                    v0[0] *= bflo(g.x); v0[1] *= bfhi(g.x); v0[2] *= bflo(g.y); v0[3] *= bfhi(g.y); v1[0] *= bflo(g.z); v1[1] *= bfhi(g.z); v1[2] *= bflo(g.w); v1[3] *= bfhi(g.w);
                    const unsigned wx = pk4_fp8(sat8(v0[0]), sat8(v0[1]), sat8(v0[2]), sat8(v0[3])), wy = pk4_fp8(sat8(v1[0]), sat8(v1[1]), sat8(v1[2]), sat8(v1[3]));
                    if (bj == 0) { w4.x = wx; w4.y = wy; } else { w4.z = wx; w4.w = wy; } }
                *(u32x4*)(MIX8 + (size_t)row * DM + col0) = w4; } }
    }
};
struct EpiResid {
    static constexpr bool PERM = true, HAS_MID = false;
    const float* X; bf16* X2; unsigned char* HN8; const float* gf;
    __device__ __forceinline__ void operator()(const f32x4 (&acc)[2][2][4][2], const Unit& u, int wr, int wc, int fr, int fq) const {
        const int row0 = u.pm * BM + wr * 64 + fr, col0 = u.pn * BM + wc * 64 + 16 * fq;
        f32x4 gv[2][2];
#pragma unroll
        for (int bj = 0; bj < 2; ++bj)
#pragma unroll
            for (int n = 0; n < 2; ++n) gv[bj][n] = *(const f32x4*)(gf + col0 + bj * 8 + n * 4);
#pragma unroll
        for (int ai = 0; ai < 2; ++ai) {
            f32x4 xv[4][2][2];
#pragma unroll
            for (int m = 0; m < 4; ++m) { const size_t off = (size_t)(row0 + ai * HALF + m * 16) * DM + col0;
#pragma unroll
                for (int bj = 0; bj < 2; ++bj)
#pragma unroll
                    for (int n = 0; n < 2; ++n) xv[m][bj][n] = *(const f32x4*)(X + off + bj * 8 + n * 4); }
#pragma unroll
            for (int m = 0; m < 4; ++m) { const size_t off = (size_t)(row0 + ai * HALF + m * 16) * DM + col0;
                u32x4 hw4;
#pragma unroll
                for (int bj = 0; bj < 2; ++bj) { constexpr float DS = 1.0f / (W8_SCALE * MIX8_SCALE); const f32x4 v0 = xv[m][bj][0] + acc[ai][bj][m][0] * DS, v1 = xv[m][bj][1] + acc[ai][bj][m][1] * DS;
                    u32x4 w; w.x = cvt_pk_bf16(v0[0], v0[1]); w.y = cvt_pk_bf16(v0[2], v0[3]); w.z = cvt_pk_bf16(v1[0], v1[1]); w.w = cvt_pk_bf16(v1[2], v1[3]);
                    *(u32x4*)(X2 + off + bj * 8) = w;
                    const f32x4 h0 = v0 * gv[bj][0], h1 = v1 * gv[bj][1]; const unsigned hx = pk4_fp8(h0[0], h0[1], h0[2], h0[3]), hy = pk4_fp8(h1[0], h1[1], h1[2], h1[3]);
                    if (bj == 0) { hw4.x = hx; hw4.y = hy; } else { hw4.z = hx; hw4.w = hy; } }
                *(u32x4*)(HN8 + off) = hw4; } }
    }
};
struct EpiSwiglu {
    static constexpr bool PERM = true, HAS_MID = false;
    unsigned char* ACT; const float* b1; const float* rowrstd;
    __device__ __forceinline__ void operator()(const f32x4 (&acc)[2][2][4][2], const Unit& u, int wr, int wc, int fr, int fq) const {
        const int row0 = u.pm * BM + wr * 64 + fr, j0 = u.pn * 128 + wc * 32 + 8 * fq;
        const float* bp = b1 + (size_t)u.e * 4096 + 2 * j0;
        const f32x4 q0 = *(const f32x4*)(bp), q1 = *(const f32x4*)(bp + 4), q2 = *(const f32x4*)(bp + 8), q3 = *(const f32x4*)(bp + 12);
        const f32x4 bg0 = {q0[0], q0[2], q1[0], q1[2]}, bl0 = {q0[1], q0[3], q1[1], q1[3]}, bg1 = {q2[0], q2[2], q3[0], q3[2]}, bl1 = {q2[1], q2[3], q3[1], q3[3]};
#pragma unroll
        for (int ai = 0; ai < 2; ++ai) { float rs[4];
#pragma unroll
            for (int m = 0; m < 4; ++m) rs[m] = rowrstd[row0 + ai * HALF + m * 16] * (1.0f / W8_SCALE);
#pragma unroll
            for (int m = 0; m < 4; ++m) { const int row = row0 + ai * HALF + m * 16; const float DS = rs[m];
                const f32x4 g0 = acc[ai][0][m][0] * DS + bg0, g1 = acc[ai][0][m][1] * DS + bg1, l0 = acc[ai][1][m][0] * DS + bl0, l1 = acc[ai][1][m][1] * DS + bl1;
                f32x2 o2[4];
#pragma unroll
                for (int p = 0; p < 4; ++p) { const f32x4& gs = (p < 2) ? g0 : g1; const f32x4& ls = (p < 2) ? l0 : l1; const int i0 = 2 * (p & 1);
                    const f32x2 ga = {fminf(gs[i0], SW_LIMIT), fminf(gs[i0 + 1], SW_LIMIT)};
                    const f32x2 la = {__builtin_amdgcn_fmed3f(ls[i0], -SW_LIMIT, SW_LIMIT), __builtin_amdgcn_fmed3f(ls[i0 + 1], -SW_LIMIT, SW_LIMIT)};
                    const f32x2 ex = ga * (-SW_ALPHA * 1.4426950408889634f);
                    const f32x2 dn = (f32x2){__builtin_amdgcn_exp2f(ex[0]), __builtin_amdgcn_exp2f(ex[1])} + 1.0f;
                    const f32x2 rc = {__builtin_amdgcn_rcpf(dn[0]), __builtin_amdgcn_rcpf(dn[1])};
                    o2[p] = (ga * rc) * (la * ACT8_SCALE + ACT8_SCALE); }
                u32x2 w; w.x = pk4_fp8(o2[0][0], o2[0][1], o2[1][0], o2[1][1]); w.y = pk4_fp8(o2[2][0], o2[2][1], o2[3][0], o2[3][1]);
                *(u32x2*)(ACT + (size_t)row * DFF + j0) = w; } }
    }
};
struct EpiDown {
    static constexpr bool PERM = true, HAS_MID = false;
    unsigned char* Y; const float* b2; const float* roww;
    __device__ __forceinline__ void operator()(const f32x4 (&acc)[2][2][4][2], const Unit& u, int wr, int wc, int fr, int fq) const {
        const int row0 = u.pm * BM + wr * 64 + fr, col0 = u.pn * BM + wc * 64 + 16 * fq;
        const float* bp = b2 + (size_t)u.e * DM + col0;
        f32x4 bv[2][2];
#pragma unroll
        for (int bj = 0; bj < 2; ++bj)
#pragma unroll
            for (int n = 0; n < 2; ++n) bv[bj][n] = *(const f32x4*)(bp + bj * 8 + 4 * n);
        float wg[2][4];
#pragma unroll
        for (int ai = 0; ai < 2; ++ai)
#pragma unroll
            for (int m = 0; m < 4; ++m) wg[ai][m] = roww[row0 + ai * HALF + m * 16] * Y8_SCALE;
#pragma unroll
        for (int ai = 0; ai < 2; ++ai)
#pragma unroll
            for (int m = 0; m < 4; ++m) { const int row = row0 + ai * HALF + m * 16; const float wgt = wg[ai][m]; unsigned char* rowp = Y + (size_t)row * DM + col0;
                u32x4 w4;
#pragma unroll
                for (int bj = 0; bj < 2; ++bj) { constexpr float DS = 1.0f / (W8_SCALE * ACT8_SCALE); const f32x4 v0 = (acc[ai][bj][m][0] * DS + bv[bj][0]) * wgt, v1 = (acc[ai][bj][m][1] * DS + bv[bj][1]) * wgt;
                    const unsigned wx = pk4_fp8(sat8(v0[0]), sat8(v0[1]), sat8(v0[2]), sat8(v0[3])), wy = pk4_fp8(sat8(v1[0]), sat8(v1[1]), sat8(v1[2]), sat8(v1[3]));
                    if (bj == 0) { w4.x = wx; w4.y = wy; } else { w4.z = wx; w4.w = wy; } }
                *(u32x4*)rowp = w4; }
    }
};
}

namespace att {
constexpr int D = 128, PQ = BW, PO = DM;
constexpr float SCALE = 0.08838834764831845f;
constexpr int NW = 8, QBLK = 32, KVBLK = 64, QB = NW * QBLK;
constexpr int SHM_V = KVBLK * D * 2, SHM_K = KVBLK * D * 2;
constexpr int BIAS_OFF = 2 * SHM_V + 2 * SHM_K + NW * 64 * 4;
constexpr int LDS_BYTES = BIAS_OFF + 2 * SEQ * 4;
constexpr float THR = 8.f;
constexpr unsigned WBIG = 1u << 30;
static_assert(LDS_BYTES <= RING_BYTES, "attention scratch inside the ring region");
#define KSWZ(row, colB) ((row) * 256 + ((colB) ^ (((row) & 7) << 4)))
#define SBAR() __builtin_amdgcn_sched_barrier(0)
__device__ __forceinline__ int v_st(int k, int c) { const int kk = (k & ~0xC) | ((k & 4) << 1) | ((k & 8) >> 1); return ((kk >> 3) * 4 + (c >> 5)) * 512 + ((kk & 7) * 32 + (c & 31)) * 2; }
__device__ __forceinline__ int v_rd_base(int lane) { return ((lane & 3) << 3) | (((lane >> 2) & 3) << 6) | (((lane >> 4) & 1) << 5) | (((lane >> 5) & 1) << 8); }
constexpr int v_rd_off(int d0, int ks, int half) { return d0 * 512 + ks * 4096 + half * 2048; }
__device__ __forceinline__ int crow(int r, int hi) { return (r & 3) + 8 * (r >> 2) + 4 * hi; }
__device__ __forceinline__ unsigned cvtpk(float lo, float hi) { return cvt_pk_bf16(lo, hi); }
__device__ __forceinline__ bf16x8 load8(const bf16* p) { return *reinterpret_cast<const bf16x8*>(p); }
__device__ __forceinline__ void mask_tile(f32x16& p0, f32x16& p1, int dq, unsigned W) {
    const float NEG = -__builtin_inff();
#pragma unroll
    for (int r = 0; r < 16; ++r) {
        const int c = (r & 3) + 8 * (r >> 2);
        if ((unsigned)(dq - c) >= W) p0[r] = NEG;
        if ((unsigned)(dq - c - 32) >= W) p1[r] = NEG;
    }
}
__device__ __forceinline__ void partialSM(f32x16& p0, f32x16& p1, float& m_reg, float& mn, float& alpha) {
    float pmax = p0[0];
#pragma unroll
    for (int r = 1; r < 16; ++r) pmax = fmaxf(pmax, p0[r]);
#pragma unroll
    for (int r = 0; r < 16; ++r) pmax = fmaxf(pmax, p1[r]);
    { auto rr = __builtin_amdgcn_permlane32_swap(__float_as_uint(pmax), __float_as_uint(pmax), false, false);
      pmax = fmaxf(__uint_as_float(rr[0]), __uint_as_float(rr[1])); }
    constexpr float C2 = 1.4426950408889634f * SCALE;
    if (__builtin_expect(__all((pmax - m_reg) * SCALE <= THR), 1)) { mn = m_reg; alpha = 1.f; }
    else { mn = fmaxf(m_reg, pmax); alpha = __builtin_amdgcn_exp2f((m_reg - mn) * C2); m_reg = mn; }
    const float mnL = -mn * C2;
#pragma unroll
    for (int r = 0; r < 16; ++r) p0[r] = fmaf(p0[r], C2, mnL);
#pragma unroll
    for (int r = 0; r < 16; ++r) p1[r] = fmaf(p1[r], C2, mnL);
#pragma unroll
    for (int r = 0; r < 16; ++r) p0[r] = __builtin_amdgcn_exp2f(p0[r]);
}
__device__ __forceinline__ void finishSM(f32x16& p0, f32x16& p1, float alpha, float& l_reg, bf16x8& pa0, bf16x8& pa1, bf16x8& pa2, bf16x8& pa3) {
#pragma unroll
    for (int r = 0; r < 16; ++r) p1[r] = __builtin_amdgcn_exp2f(p1[r]);
    float ps = 0;
#pragma unroll
    for (int r = 0; r < 16; ++r) ps += p0[r];
#pragma unroll
    for (int r = 0; r < 16; ++r) ps += p1[r];
    { auto rr = __builtin_amdgcn_permlane32_swap(__float_as_uint(ps), __float_as_uint(ps), false, false);
      ps = __uint_as_float(rr[0]) + __uint_as_float(rr[1]); }
    l_reg = l_reg * alpha + ps;
#define PK4(P, B_, OUT) do { unsigned a0 = cvtpk(P[B_+0], P[B_+1]), a1 = cvtpk(P[B_+2], P[B_+3]);                          \
        unsigned b0 = cvtpk(P[B_+4], P[B_+5]), b1 = cvtpk(P[B_+6], P[B_+7]);                                             \
        auto r0 = __builtin_amdgcn_permlane32_swap(a0, b0, false, false); auto r1 = __builtin_amdgcn_permlane32_swap(a1, b1, false, false); \
        u32x4 w = {r0[0], r1[0], r0[1], r1[1]}; OUT = *reinterpret_cast<bf16x8*>(&w); } while (0)
    PK4(p0, 0, pa0); PK4(p0, 8, pa1); PK4(p1, 0, pa2); PK4(p1, 8, pa3);
#undef PK4
}
template <int KB>
__device__ __forceinline__ void qkt(f32x16& p0, f32x16& p1, const LAS char* K_lds, const LAS char* bt, int r32, int hi, const bf16x8* qr) {
#pragma unroll
    for (int g = 0; g < 4; ++g) { const f32x4 a = *(const LAS f32x4*)(bt + 32 * g), b = *(const LAS f32x4*)(bt + 128 + 32 * g);
        p0[4 * g + 0] = a[0]; p0[4 * g + 1] = a[1]; p0[4 * g + 2] = a[2]; p0[4 * g + 3] = a[3]; p1[4 * g + 0] = b[0]; p1[4 * g + 1] = b[1]; p1[4 * g + 2] = b[2]; p1[4 * g + 3] = b[3]; }
    const LAS char* kb[4];
#pragma unroll
    for (int dd = 0; dd < 4; ++dd) kb[dd] = K_lds + KB * SHM_K + KSWZ(r32, (dd * 16 + hi * 8) * 2);
#pragma unroll
    for (int d0 = 0; d0 < 8; ++d0) { const LAS char* a = kb[d0 & 3] + (d0 >> 2) * 128;
        bf16x8 b0 = *reinterpret_cast<const LAS bf16x8*>(a);
        bf16x8 b1 = *reinterpret_cast<const LAS bf16x8*>(a + 32 * 256);
        p0 = __builtin_amdgcn_mfma_f32_32x32x16_bf16(b0, qr[d0], p0, 0, 0, 0);
        p1 = __builtin_amdgcn_mfma_f32_32x32x16_bf16(b1, qr[d0], p1, 0, 0, 0); }
}
template <int VB>
__device__ __forceinline__ void pv_tile(f32x16* o, int vb0, bf16x8 pa0, bf16x8 pa1, bf16x8 pa2, bf16x8 pa3) {
#define TRRD(dst, off) asm volatile("ds_read_b64_tr_b16 %0, %1 offset:%2" : "=&v"(dst) : "v"(vb0), "i"(off) : "memory")
#define PV_D0(d0) do { s16x4 l0, l1, l2, l3, h0, h1, h2, h3; constexpr int b_ = VB * SHM_V + v_rd_off(d0, 0, 0); \
        TRRD(l0, b_); TRRD(h0, b_ + 2048); TRRD(l1, b_ + 4096); TRRD(h1, b_ + 6144); TRRD(l2, b_ + 8192); TRRD(h2, b_ + 10240); TRRD(l3, b_ + 12288); TRRD(h3, b_ + 14336); \
        asm volatile("s_waitcnt lgkmcnt(0)" ::: "memory"); SBAR();   \
        o[d0] = __builtin_amdgcn_mfma_f32_32x32x16_bf16(pa0, (bf16x8){l0[0], l0[1], l0[2], l0[3], h0[0], h0[1], h0[2], h0[3]}, o[d0], 0, 0, 0);   \
        o[d0] = __builtin_amdgcn_mfma_f32_32x32x16_bf16(pa1, (bf16x8){l1[0], l1[1], l1[2], l1[3], h1[0], h1[1], h1[2], h1[3]}, o[d0], 0, 0, 0);   \
        o[d0] = __builtin_amdgcn_mfma_f32_32x32x16_bf16(pa2, (bf16x8){l2[0], l2[1], l2[2], l2[3], h2[0], h2[1], h2[2], h2[3]}, o[d0], 0, 0, 0);   \
        o[d0] = __builtin_amdgcn_mfma_f32_32x32x16_bf16(pa3, (bf16x8){l3[0], l3[1], l3[2], l3[3], h3[0], h3[1], h3[2], h3[3]}, o[d0], 0, 0, 0); } while (0)
    PV_D0(0); PV_D0(1); PV_D0(2); PV_D0(3);
#undef PV_D0
#undef TRRD
}
struct BlockRef { const bf16* Q; const bf16* K; const bf16* V; unsigned char* O; const float* bias; const unsigned* sel; int P0; };
struct Seam { bf16x8 qr[8]; bf16x8 st_v0, st_v1, st_k0, st_k1; int par; };
#define VMW() asm volatile("s_waitcnt vmcnt(0)" ::: "memory")
#define VMWN(n) asm volatile("s_waitcnt vmcnt(%0)" :: "i"(n) : "memory")
#define SLOAD_H(Kp, Vp, k0) do { const char* kp_ = (const char*)(Kp) + (size_t)(k0) * (PQ * 2); const char* vp_ = (const char*)(Vp) + (size_t)(k0) * (PQ * 2);   \
                         S.st_v0 = *(const bf16x8*)(vp_ + kvo); S.st_v1 = *(const bf16x8*)(vp_ + 32 * PQ * 2 + kvo);                                 \
                         S.st_k0 = *(const bf16x8*)(kp_ + kvo); S.st_k1 = *(const bf16x8*)(kp_ + 32 * PQ * 2 + kvo); } while (0)
#define QLOAD(Qp) do { const char* qp_ = (const char*)(Qp) + (size_t)(wid * QBLK) * (PQ * 2); _Pragma("unroll") for (int d0 = 0; d0 < 8; ++d0) S.qr[d0] = *(const bf16x8*)(qp_ + d0 * 32 + qo); } while (0)
#define SWRITE_HK(bf) do { *(LAS bf16x8*)(K_lds + (bf) * SHM_K + kws) = S.st_k0; *(LAS bf16x8*)(K_lds + (bf) * SHM_K + kws + 32 * 256) = S.st_k1; } while (0)
#define SWRITE_HV(bf) do { *(LAS bf16x8*)(V_lds + (bf) * SHM_V + vst0) = S.st_v0; *(LAS bf16x8*)(V_lds + (bf) * SHM_V + vst1) = S.st_v1; } while (0)
#define SWRITE_H(bf) do { SWRITE_HV(bf); SWRITE_HK(bf); } while (0)
__device__ __forceinline__ void attn_prime(const BlockRef& cur, LAS char* lds, Seam& S, int wave) {
    const int wid = wave, lane = lane_now(), tid = wid * 64 + lane, r32 = lane & 31, hi = lane >> 5;
    const int sr = tid >> 4, sc = (tid & 15) * 8, kws = KSWZ(sr, sc * 2); LAS char* K_lds = lds + 2 * SHM_V;
    const unsigned kvo = (unsigned)(sr * PQ + sc) * 2u, qo = (unsigned)(r32 * PQ + hi * 8) * 2u;
    QLOAD(cur.Q);
    const f32x4 bz = *(const f32x4*)(cur.bias + tid * 4);
    SLOAD_H(cur.K, cur.V, 0); VMW(); SWRITE_HK(0);
    *(LAS f32x4*)(lds + BIAS_OFF + tid * 16) = bz; S.par = 0;
    __syncthreads();
}
__device__ __forceinline__ void attn_block(const BlockRef& cur, const BlockRef& nxt, LAS char* lds, Seam& S, int wave) {
    const int wid = wave, lane = lane_now(), tid = wid * 64 + lane, r32 = lane & 31, hi = lane >> 5;
    const int NT = (cur.P0 + QB - 1) / KVBLK + 1;
    const int qlo = cur.P0 + wid * QBLK, qm = qlo + r32 - 4 * hi;
    LAS char* V_lds = lds; LAS char* K_lds = lds + 2 * SHM_V;
    LAS float* ws = (LAS float*)(lds + 2 * SHM_V + 2 * SHM_K) + wid * 64; LAS float* li_l = ws; LAS float* al_l = ws + 32;
    const LAS char* bias_l = lds + BIAS_OFF + S.par * (SEQ * 4) + 16 * hi;
    float m_reg = *(const LAS float*)(lds + BIAS_OFF + S.par * (SEQ * 4) + 4 * (qlo + r32)), l_reg = 0; f32x16 o[4] = {};
    const int sr = tid >> 4, sc = (tid & 15) * 8, vst0 = v_st(sr, sc), vst1 = v_st(32 + sr, sc), kws = KSWZ(sr, sc * 2);
    const unsigned kvo = (unsigned)(sr * PQ + sc) * 2u, qo = (unsigned)(r32 * PQ + hi * 8) * 2u, oo = (unsigned)(4 * hi * PO + r32);
    const int vb0 = (int)(unsigned)(size_t)V_lds + v_rd_base(lane);
    const bf16* Kh = cur.K; const bf16* Vh = cur.V;
    unsigned so_ = (unsigned)((wid * QBLK + r32) * 4); asm volatile("" : "+v"(so_));
    const unsigned selw = cur.sel ? *(const unsigned*)((const char*)cur.sel + so_) : 0xffffffffu; const int P0 = cur.P0;
    const f32x4 bz = *(const f32x4*)(nxt.bias + tid * 4);
#define RESC(a) do { if (__any((a) < 1.f)) { if (hi == 0) al_l[r32] = (a); asm volatile("s_waitcnt lgkmcnt(0)" ::: "memory");              \
                     for (int d_ = 0; d_ < 4; ++d_) for (int r = 0; r < 16; ++r) o[d_][r] *= al_l[crow(r, hi)]; } } while (0)
#define KBASE(t) ((t) * KVBLK)
#define MASKT(P0_, P1_, t) do { const int kb_ = KBASE(t); if (kb_ + KVBLK - 1 > qlo) mask_tile(P0_, P1_, qm - kb_, WBIG);                                  \
        if (kb_ < P0) { const bool keep_ = ((selw >> (kb_ >> 8)) & 1u) != 0u; if (!__all(keep_)) { const float NEG_ = -__builtin_inff();                     \
            _Pragma("unroll") for (int r = 0; r < 16; ++r) { P0_[r] = keep_ ? P0_[r] : NEG_; P1_[r] = keep_ ? P1_[r] : NEG_; } } } } while (0)
    constexpr int NQL = 8;
#define SEAM_K0() do { VMWN(NQL); SWRITE_HK(0); SBAR(); } while (0)
    f32x16 pA0, pA1, pB0, pB1; float mnA, mnB, alA, alB; bf16x8 pa0, pa1, pa2, pa3;
    SWRITE_HV(0); SBAR();
    if (NT > 1) { SLOAD_H(Kh, Vh, KBASE(1)); }
    SBAR(); qkt<0>(pA0, pA1, K_lds, bias_l + 4 * KBASE(0), r32, hi, S.qr);
    MASKT(pA0, pA1, 0); partialSM(pA0, pA1, m_reg, mnA, alA);
    if (NT > 1) { VMW(); SWRITE_H(1); }
    *(LAS f32x4*)(lds + BIAS_OFF + (S.par ^ 1) * (SEQ * 4) + tid * 16) = bz;
    __syncthreads();
#define HALF_STEP(PX0, PX1, mnX, alX, PY0, PY1, alY, t, KB, VB, SB) do {                                                      \
        SBAR(); qkt<KB>(PX0, PX1, K_lds, bias_l + 4 * KBASE(t), r32, hi, S.qr);                                               \
        finishSM(PY0, PY1, alY, l_reg, pa0, pa1, pa2, pa3); SBAR();                                                           \
        if ((t) + 1 < NT) { SLOAD_H(Kh, Vh, KBASE((t) + 1)); SBAR(); }                                                        \
        pv_tile<VB>(o, vb0, pa0, pa1, pa2, pa3); MASKT(PX0, PX1, (t)); partialSM(PX0, PX1, m_reg, mnX, alX);                  \
        __syncthreads();                                                                                                      \
        if ((t) + 1 < NT) { VMW(); SWRITE_H(SB); }                                                                            \
        RESC(alX); __syncthreads(); } while (0)
    for (int t = 1; t + 1 < NT; t += 2) {
        HALF_STEP(pB0, pB1, mnB, alB, pA0, pA1, alA, t, 1, 0, 0);
        HALF_STEP(pA0, pA1, mnA, alA, pB0, pB1, alB, t + 1, 0, 1, 1);
    }
    const bool even = (NT & 1) == 0;
    if (even) { SBAR(); qkt<1>(pB0, pB1, K_lds, bias_l + 4 * KBASE(NT - 1), r32, hi, S.qr); SBAR(); }
    SLOAD_H(nxt.K, nxt.V, 0); SBAR();
    QLOAD(nxt.Q);
    SBAR();
    finishSM(pA0, pA1, alA, l_reg, pa0, pa1, pa2, pa3); SBAR();
    pv_tile<0>(o, vb0, pa0, pa1, pa2, pa3);
    if (even) { MASKT(pB0, pB1, NT - 1); partialSM(pB0, pB1, m_reg, mnB, alB); __syncthreads(); RESC(alB);
        finishSM(pB0, pB1, alB, l_reg, pa0, pa1, pa2, pa3); SBAR(); pv_tile<1>(o, vb0, pa0, pa1, pa2, pa3); }
    SBAR(); SEAM_K0();
    if (hi == 0) li_l[r32] = l_reg; asm volatile("s_waitcnt lgkmcnt(0)" ::: "memory");
    float rli[16];
#pragma unroll
    for (int r = 0; r < 16; ++r) rli[r] = __builtin_amdgcn_rcpf(li_l[crow(r, hi)]);
    char* Ow = (char*)cur.O + (size_t)(wid * QBLK) * PO;
#pragma unroll
    for (int r = 0; r < 16; ++r) { char* Or = Ow + (size_t)((r & 3) + 8 * (r >> 2)) * PO;
#pragma unroll
        for (int d0 = 0; d0 < 4; ++d0) { const float v = o[d0][r] * (rli[r] * O8_SCALE);
            const float vn = __shfl_xor(v, 1);
            const unsigned pr = __builtin_amdgcn_cvt_pk_fp8_f32(v, vn, 0u, false) & 0xffffu; const unsigned pn = (unsigned)__shfl_xor((int)pr, 2);
            if ((r32 & 3) == 0) *(unsigned*)(Or + d0 * 32 + oo) = pr | (pn << 16); } }
    S.par ^= 1;
    __syncthreads();
#undef RESC
#undef KBASE
#undef MASKT
#undef SEAM_K0
#undef HALF_STEP
}
#undef QLOAD
#undef VMW
#undef VMWN
#undef SLOAD_H
#undef SWRITE_HK
#undef SWRITE_HV
#undef SWRITE_H
#undef KSWZ
}

#define XB_TMO      128
#define XB_XCNT(j)  (256  + 64 * (j))
#define XB_XSUB(j)  (1280 + 64 * (j))
#define XB_XGEN(j)  (2304 + 64 * (j))
#define XB_TOP      3328
#define XB_TOPGEN   3392
#define XCD_BAR_WORDS 3456
#define XB_SPIN_CAP (1u << 18)
__device__ __forceinline__ unsigned xb_ld(unsigned* p)              { return __hip_atomic_load(p, __ATOMIC_RELAXED, __HIP_MEMORY_SCOPE_AGENT); }
__device__ __forceinline__ unsigned xb_add(unsigned* p, unsigned v) { return __hip_atomic_fetch_add(p, v, __ATOMIC_RELAXED, __HIP_MEMORY_SCOPE_AGENT); }
__device__ __forceinline__ unsigned xb_xcc_id() { return (unsigned)__builtin_amdgcn_s_getreg((3 << 11) | 20) & 0xFu; }
#define XB_SPIN(cond, bar) do { unsigned _sp = 0; while (cond) { __builtin_amdgcn_s_sleep(1); \
    if ((++_sp & 255u) == 0u) { if (xb_ld(&(bar)[XB_TMO])) break; if (_sp > XB_SPIN_CAP) { atomicAdd(&(bar)[XB_TMO], 1u); break; } } } } while (0)
struct XcdBarrier { unsigned* bar; unsigned x; volatile LAS unsigned* st; int wave; };
__device__ __forceinline__ XcdBarrier xcd_barrier_post(unsigned* bar, volatile LAS unsigned* st, int wave) {
    XcdBarrier b; b.bar = bar; b.x = xb_xcc_id(); b.st = st; b.wave = wave;
    if (wave == 0 && lane_now() == 0) (void)xb_add(&bar[XB_XCNT(b.x)], 1u);
    return b;
}
__device__ __forceinline__ void xcd_barrier_complete(unsigned* bar, unsigned x, unsigned& nloc, unsigned& nx) {
    const unsigned G = gridDim.x * gridDim.y * gridDim.z;
    unsigned sum, cnt, mine, sp = 0u;
    for (;;) {
        sum = 0u; cnt = 0u; mine = 0u;
#pragma unroll
        for (unsigned j = 0; j < 16; ++j) { const unsigned c = xb_ld(&bar[XB_XCNT(j)]); sum += c; cnt += (c > 0u) ? 1u : 0u; mine = (j == x) ? c : mine; }
        if (sum == G) break;
        __builtin_amdgcn_s_sleep(1);
        if ((++sp & 255u) == 0u) { if (xb_ld(&bar[XB_TMO])) break; if (sp > XB_SPIN_CAP) { atomicAdd(&bar[XB_TMO], 1u); break; } }
    }
    nloc = mine > 0u ? mine : 1u; nx = cnt > 0u ? cnt : 1u;
}
__device__ __forceinline__ void xcd_barrier(const XcdBarrier& b) {
    asm volatile("s_waitcnt vmcnt(0)" ::: "memory");
    __syncthreads();
    if (b.wave == 0 && lane_now() == 0) {
        unsigned* bar = b.bar;
        __builtin_amdgcn_s_waitcnt(0);
        unsigned nloc = b.st[0], nx = b.st[1];
        if (nloc == 0u) { xcd_barrier_complete(bar, b.x, nloc, nx); b.st[0] = nloc; b.st[1] = nx; }
        const unsigned old = xb_add(&bar[XB_XSUB(b.x)], 1u);
        const unsigned gen = old / nloc;
        if (old + 1u == (gen + 1u) * nloc) {
            __builtin_amdgcn_fence(__ATOMIC_RELEASE, "agent");
            asm volatile("s_waitcnt vmcnt(0)" ::: "memory");
            const unsigned og = xb_add(&bar[XB_TOP], 1u);
            const unsigned tg = og / nx;
            if (og + 1u == (tg + 1u) * nx) xb_add(&bar[XB_TOPGEN], 1u);
            else XB_SPIN(xb_ld(&bar[XB_TOPGEN]) == tg, bar);
            __builtin_amdgcn_fence(__ATOMIC_ACQUIRE, "agent");
            xb_add(&bar[XB_XGEN(b.x)], 1u);
            asm volatile("s_waitcnt vmcnt(0)" ::: "memory");
        } else {
            XB_SPIN(xb_ld(&bar[XB_XGEN(b.x)]) == gen, bar);
            __builtin_amdgcn_fence(__ATOMIC_ACQUIRE, "agent");
            asm volatile("s_waitcnt vmcnt(0)" ::: "memory");
        }
    }
    __syncthreads();
}

struct Args { const float* in[15]; float* out; unsigned char* ws; int ph_lo, ph_hi; };
struct Frame {
    LAS unsigned char* lds; volatile LAS unsigned* MISC; unsigned* ctl;
    int tid, lane, wave, vcu, G, gw, NGW;
    unsigned char* ws;
};
__device__ const float kInvFreq[16] = {1.0f, 0.44036662578582764f, 0.193922758102417f, 0.08539710193872452f, 0.03760603070259094f, 0.016560440883040428f, 0.00729266507551074f, 0.0032114461064338684f,
    0.001414213445968926f, 0.0006227724370546639f, 0.00027424818836152554f, 0.00012076974235242233f, 5.318296462064609e-05f, 2.3419997887685895e-05f, 1.0313385246263351e-05f, 4.541670477919979e-06f};

template <int MAP  >
__device__ __forceinline__ void p0_strip(const float* W, int ldw, int k0, int nsrc0, unsigned char* WT, int K, int nv0, float scale, int lane, LAS unsigned char* wl) {
    asm volatile("" : "+v"(lane));
    const int rg = lane >> 4, cg = lane & 15;
    const unsigned so = (unsigned)((k0 + 16 * rg) * ldw + nsrc0 + 4 * cg) * 4u, sld = (unsigned)ldw * 4u;
    f32x4 va[16], vb[16], vc[16];
#define P0_LOAD(v, kk) do { _Pragma("unroll") for (int j = 0; j < 16; ++j) v[j] = __builtin_nontemporal_load((const f32x4*)((const char*)W + (so + (unsigned)((kk) + j) * sld))); } while (0)
#define P0_CONV(v, kk) do { _Pragma("unroll") for (int i = 0; i < 4; ++i) { u32x4 o; \
            o.x = pk4_fp8(v[0][i] * scale, v[1][i] * scale, v[2][i] * scale, v[3][i] * scale); o.y = pk4_fp8(v[4][i] * scale, v[5][i] * scale, v[6][i] * scale, v[7][i] * scale); \
            o.z = pk4_fp8(v[8][i] * scale, v[9][i] * scale, v[10][i] * scale, v[11][i] * scale); o.w = pk4_fp8(v[12][i] * scale, v[13][i] * scale, v[14][i] * scale, v[15][i] * scale); \
            *(LAS u32x4*)(wl + (4 * cg + i) * 144 + ((kk) & 64) + 16 * rg) = o; } } while (0)
#define P0_FLUSH(kh) do { _Pragma("unroll") for (int s_ = 0; s_ < 8; ++s_) { const int r_ = (lane >> 3) + 8 * s_, nv_ = nv0 + r_; int row_ = nv_; if (MAP == 1) { const int jj_ = nv_ >> 1; row_ = ((jj_ >> 7) << 8) + ((jj_ & 120) << 1) + ((nv_ & 1) << 3) + (jj_ & 7); } \
            const u32x4 o_ = *(const LAS u32x4*)(wl + r_ * 144 + (lane & 7) * 16); __builtin_nontemporal_store(o_, (GAS u32x4*)(WT + (size_t)row_ * K + k0 + (kh) + (lane & 7) * 16)); } } while (0)
    P0_LOAD(va, 0); P0_LOAD(vb, 64); P0_LOAD(vc, 128);
    P0_CONV(va, 0);   asm volatile("" ::: "memory"); P0_LOAD(va, 192);
    P0_CONV(vb, 64);  P0_FLUSH(0); asm volatile("" ::: "memory");
    P0_CONV(vc, 128); asm volatile("" ::: "memory");
    P0_CONV(va, 192); P0_FLUSH(128);
#undef P0_LOAD
#undef P0_CONV
#undef P0_FLUSH
}
__device__ __forceinline__ void sincos_d(double a, float& c, float& s) {
    const double k = __builtin_rint(a * 0.63661977236758134308);
    double r = __builtin_fma(-k, 1.57079632679489655800e+00, a); r = __builtin_fma(-k, 6.12323399573676603587e-17, r);
    const double r2 = r * r;
    double sp = -1.0 / 1307674368000.0; sp = sp * r2 + 1.0 / 6227020800.0; sp = sp * r2 - 1.0 / 39916800.0; sp = sp * r2 + 1.0 / 362880.0; sp = sp * r2 - 1.0 / 5040.0; sp = sp * r2 + 1.0 / 120.0; sp = sp * r2 - 1.0 / 6.0; sp = sp * r2 * r + r;
    double cp = 1.0 / 20922789888000.0; cp = cp * r2 - 1.0 / 87178291200.0; cp = cp * r2 + 1.0 / 479001600.0; cp = cp * r2 - 1.0 / 3628800.0; cp = cp * r2 + 1.0 / 40320.0; cp = cp * r2 - 1.0 / 720.0; cp = cp * r2 + 1.0 / 24.0; cp = cp * r2 - 0.5; cp = cp * r2 + 1.0;
    const int q = ((int)k) & 3;
    const double cc = (q == 0) ? cp : (q == 1) ? -sp : (q == 2) ? -cp : sp;
    const double ss = (q == 0) ? sp : (q == 1) ? cp : (q == 2) ? -sp : -cp;
    c = (float)cc; s = (float)ss;
}

__global__ void __launch_bounds__(NWAVES * 64, 2) fwd_kernel(Args args) {
    extern __shared__ __attribute__((aligned(16))) unsigned char lds[];
    Frame F;
    F.lds = (LAS unsigned char*)lds; F.MISC = (volatile LAS unsigned*)(F.lds + MISC_OFF);
    F.tid = threadIdx.x; F.lane = F.tid & 63; F.wave = __builtin_amdgcn_readfirstlane(F.tid >> 6);
    F.G = gridDim.x; { const int bx = blockIdx.x; F.vcu = (F.G % 8 == 0) ? (bx % 8) * (F.G / 8) + bx / 8 : bx; }
    F.gw = F.vcu * NWAVES + F.wave; F.NGW = F.G * NWAVES;
    F.ws = args.ws; F.ctl = (unsigned*)(args.ws + WS_CTL);
    unsigned char* const ws = args.ws;
    for (int u = F.tid; u < (LDS_BYTES - LDSCTL_OFF) / 4; u += NWAVES * 64) ((LAS unsigned*)(F.lds + LDSCTL_OFF))[u] = 0u;
    __syncthreads();
    XcdBarrier bar; bar.bar = F.ctl + CW_BAR; bar.x = 0; bar.st = nullptr; bar.wave = 0;
    if (!MK_PER_PHASE) bar = xcd_barrier_post(F.ctl + CW_BAR, F.MISC + 8, F.wave);
#define GRID_BAR() do { if (!MK_PER_PHASE) xcd_barrier(bar); } while (0)
    const int lo = args.ph_lo, hi = args.ph_hi;
#define IN(k) (lo <= (k) && (k) < hi)
#define BOTH(k) (IN(k) && IN((k) + 1))
    const float* x = args.in[0]; const float* g_mix = args.in[1]; const float* w_in = args.in[2]; const float* b_forget = args.in[3];
    const float* w_fox = args.in[4]; const float* w_moba = args.in[5]; const float* w_out = args.in[6]; const float* g_ffn = args.in[7];
    const float* w_router = args.in[8]; const float* b_router = args.in[9]; const float* w_mlp1 = args.in[10]; const float* b_mlp1 = args.in[11];
    const float* w_mlp2 = args.in[12]; const float* b_mlp2 = args.in[13]; const float* g_final = args.in[14];
    unsigned char* Wt_in = ws + WS_WIN; unsigned char* Wt_cat = ws + WS_WFOX; unsigned char* Wt_out = ws + WS_WOUT;
    unsigned char* Wt_1 = ws + WS_W1; unsigned char* Wt_2 = ws + WS_W2; float* WR = (float*)(ws + WS_WR);
    float* RCOS = (float*)(ws + WS_ROPE); float* RSIN = RCOS + SEQ * 16;
    float* LOGF = (float*)(ws + WS_LOGF); float* BIAS = (float*)(ws + WS_BIAS); float* KMEAN = (float*)(ws + WS_KMEAN); unsigned* SELB = (unsigned*)(ws + WS_SELB);
    int* EIDX = (int*)(ws + WS_EIDX); float* EW = (float*)(ws + WS_EW); int* RANK = (int*)(ws + WS_RANK); int* POS = (int*)(ws + WS_POS); float* RSTD = (float*)(ws + WS_RSTD); float* ROWW = (float*)(ws + WS_ROWW);
    unsigned char* Hb = ws + WS_H; bf16* QKV = (bf16*)(ws + WS_QKV); bf16* SG = (bf16*)(ws + WS_SG); unsigned char* Ob = ws + WS_O; unsigned char* MIX8 = ws + WS_H;
    bf16* X2 = (bf16*)(ws + WS_X2); unsigned char* HN8 = ws + WS_AS; int* ROWTOK = (int*)(ws + WS_AS + 64 * MiB); float* ROWRSTD = (float*)(ws + WS_AS + 65 * MiB); unsigned char* ACT = ws + WS_ACT;
    unsigned char* Yb = ws + WS_Y;

    if (IN(0)) {
    _Pragma("unroll") for (int rep_ = 0; rep_ <= REP(0); ++rep_) {
        constexpr int I_IN = (NV_IN / 64) * 8, I_BR = 32 * 4, I_OUT = 32 * 8, I_W1 = 64 * 8, I_W2 = 32 * 8;
        constexpr int NITEMS = I_IN + 2 * I_BR + I_OUT;
        LAS unsigned char* wl = F.lds + F.wave * 9216;
        _Pragma("unroll") for (int rp_ = 0; rp_ <= REP(12); ++rp_)
        for (int it = F.gw; it < NITEMS; it += F.NGW) {
            int r = it;
            if (r < I_IN) { const int nb = r >> 3, kb = r & 7, nv0 = 64 * nb; p0_strip<0>(w_in, IN_COLS, 256 * kb, nv0 + (nv0 >= FL_COL ? 8 : 0), Wt_in, DM, nv0, W8_SCALE, F.lane, wl); continue; } r -= I_IN;
            if (r < I_BR) { const int nb = r >> 2, kb = r & 3; p0_strip<0>(w_fox, DM, 256 * kb, 64 * nb, Wt_cat, DM, 64 * nb, W8_SCALE, F.lane, wl); continue; } r -= I_BR;
            if (r < I_BR) { const int nb = r >> 2, kb = r & 3; p0_strip<0>(w_moba, DM, 256 * kb, 64 * nb, Wt_cat + BW, DM, 64 * nb, W8_SCALE, F.lane, wl); continue; } r -= I_BR;
            { const int nb = r >> 3, kb = r & 7; p0_strip<0>(w_out, DM, 256 * kb, 64 * nb, Wt_out, DM, 64 * nb, W8_SCALE, F.lane, wl); }
        }
        for (int i = F.gw * 64 + F.lane; i < SEQ * 16; i += F.NGW * 64) { const int pos = i >> 4, j = i & 15; const float ang = (float)pos * kInvFreq[j]; float c, s; sincos_d((double)ang, c, s); RCOS[i] = c; RSIN[i] = s; }
        for (int i = F.gw * 64 + F.lane; i < 64 * 1024; i += F.NGW * 64) { const int c = i >> 10, ln = (i >> 4) & 63, eh = (i >> 3) & 1, s = i & 7, k = 32 * c + 8 * (ln >> 4) + s, e = (ln & 15) + 16 * eh; WR[i] = g_ffn[k] * w_router[k * NE + e]; }
        __syncthreads();
        LAS float* wf = (LAS float*)F.lds;
        for (int k = F.tid; k < DM; k += NWAVES * 64) { const float g = g_mix[k]; const f32x4 a = *(const f32x4*)(w_in + (size_t)k * IN_COLS + FL_COL), b = *(const f32x4*)(w_in + (size_t)k * IN_COLS + FL_COL + 4);
            wf[0 * DM + k] = a[0] * g; wf[1 * DM + k] = a[1] * g; wf[2 * DM + k] = a[2] * g; wf[3 * DM + k] = a[3] * g; wf[4 * DM + k] = b[0] * g; wf[5 * DM + k] = b[1] * g; wf[6 * DM + k] = b[2] * g; wf[7 * DM + k] = b[3] * g; }
        __syncthreads();
        { f32x4 vn[8];
          { const f32x4* xr0 = (const f32x4*)(x + (size_t)F.gw * DM) + F.lane;
#pragma unroll
            for (int j = 0; j < 8; ++j) vn[j] = xr0[64 * j]; }
          for (int m = F.gw; m < T; m += F.NGW) {
            f32x4 v[8]; float ss = 0.f;
#pragma unroll
            for (int j = 0; j < 8; ++j) { v[j] = vn[j]; ss += (v[j][0] * v[j][0] + v[j][1] * v[j][1]) + (v[j][2] * v[j][2] + v[j][3] * v[j][3]); }
            if (m + F.NGW < T) { const f32x4* xr1 = (const f32x4*)(x + (size_t)(m + F.NGW) * DM) + F.lane;
#pragma unroll
                for (int j = 0; j < 8; ++j) vn[j] = xr1[64 * j]; }
            float fl[8];
#pragma unroll
            for (int jj = 0; jj < 8; ++jj) fl[jj] = 0.f;
#pragma unroll
            for (int j = 0; j < 8; ++j) {
#pragma unroll
                for (int jj = 0; jj < 8; ++jj) { const f32x4 w = *(const LAS f32x4*)(wf + jj * DM + 4 * F.lane + 256 * j); fl[jj] += (v[j][0] * w[0] + v[j][1] * w[1]) + (v[j][2] * w[2] + v[j][3] * w[3]); }
                asm volatile("" ::: "memory"); }
#pragma unroll
            for (int o = 1; o < 64; o <<= 1) { ss += __shfl_xor(ss, o);
#pragma unroll
                for (int jj = 0; jj < 8; ++jj) fl[jj] += __shfl_xor(fl[jj], o); }
            const float rstd = 1.0f / sqrtf(ss * (1.0f / DM) + RMS_EPS);
            unsigned* o4 = (unsigned*)(Hb + (size_t)m * DM) + F.lane;
#pragma unroll
            for (int j = 0; j < 8; ++j) { const f32x4 g = *((const f32x4*)g_mix + F.lane + 64 * j); o4[64 * j] = pk4_fp8(v[j][0] * rstd * g[0], v[j][1] * rstd * g[1], v[j][2] * rstd * g[2], v[j][3] * rstd * g[3]); }
            if (F.lane < 8) { float z = 0.f;
#pragma unroll
                for (int jj = 0; jj < 8; ++jj) z = (F.lane == jj) ? fl[jj] : z;
                z = z * rstd + b_forget[F.lane]; LOGF[(size_t)m * 8 + F.lane] = fminf(z, 0.f) - log1pf(expf(-fabsf(z))); }
          } }
    if (REP(0) && rep_ == 0) { VM_WAIT(); __syncthreads(); } }
        if (BOTH(0)) GRID_BAR();
    }

    if (IN(1)) {
    _Pragma("unroll") for (int rep_ = 0; rep_ <= REP(1); ++rep_) {
        pg8::Gemm g{DM, DM, DM}; pg8::DenseOrder S; S.init(Hb, Wt_in, DM, DM, T, NV_IN, F.G, (int)blockIdx.x, 1); S.rep = 1 + REP(14);
        pg8::EpiInProj E{QKV, SG};
        pg8::gemm_phase<pg8::EpiInProj, pg8::DenseOrder, true, false, true>(F.lds, g, S, E, F.wave);
    if (REP(1) && rep_ == 0) { VM_WAIT(); __syncthreads(); } }
        if (BOTH(1)) GRID_BAR();
    }

    const int cls = (int)blockIdx.x & 7, rin = (int)blockIdx.x >> 3;
    const int ngrp = F.G >> 6, nconv = ngrp ? ngrp * 8 * CONV_PER8 : F.G;
    const int r8 = rin & 7, cslot = (r8 * CONV_PER8) >> 3;
    const bool conv8 = r8 == ((cslot * 8 + CONV_PER8 - 1) / CONV_PER8);
    const bool is_conv = ngrp == 0 || ((int)blockIdx.x < ngrp * 64 && conv8);
    const bool ov24 = IN(2) && IN(4) && ngrp != 0 && (F.G & 63) == 0 && !MK_PER_PHASE;
    int gw2 = F.gw, ngw2 = F.NGW;
    if (ov24 && !is_conv) { const int below = (r8 * CONV_PER8 + 7) >> 3;
        gw2 = ((((rin >> 3) * (8 - CONV_PER8) + (r8 - below)) * 8 + cls) * NWAVES) + F.wave; ngw2 = (F.G - nconv) * NWAVES; }
    if (IN(2) && !(ov24 && is_conv)) {
        const int lane2 = (int)__builtin_amdgcn_mbcnt_hi(~0u, __builtin_amdgcn_mbcnt_lo(~0u, 0u));
        for (int it = gw2; it < NB * NH; it += ngw2) { const int b = it >> 3, h = it & 7; const float* lf = LOGF + (size_t)b * SEQ * 8 + h; float v[32]; double tot = 0.0;
#pragma unroll
            for (int i = 0; i < 32; ++i) { v[i] = lf[(size_t)(32 * lane2 + i) * 8]; tot += (double)v[i]; }
            double inc = tot;
#pragma unroll
            for (int o = 1; o < 64; o <<= 1) { const double t = __shfl_up(inc, o); if (lane2 >= o) inc += t; }
            double run = inc - tot; float* bo = BIAS + (size_t)it * SEQ + 32 * lane2;
#pragma unroll
            for (int i = 0; i < 32; ++i) { run += (double)v[i]; bo[i] = (float)(-run * 11.313708498984761); } }
        bf16* Qm = QKV + 3 * QKV_STRIDE; bf16* Km = QKV + 4 * QKV_STRIDE;
        for (int m0 = gw2; m0 < T; m0 += 4 * ngw2) {
            const int i2 = 2 * (lane2 & 7); unsigned w1[4], w2[4]; f32x2 cs[4], sn[4];
#pragma unroll
            for (int r = 0; r < 4; ++r) { const int mr = m0 + r * ngw2, m = mr < T ? mr : m0, pos = m & (SEQ - 1); const bf16* qp = Qm + (size_t)m * BW + (lane2 >> 3) * HD + i2;
                w1[r] = *(const unsigned*)qp; w2[r] = *(const unsigned*)(qp + 16); cs[r] = *(const f32x2*)(RCOS + pos * 16 + i2); sn[r] = *(const f32x2*)(RSIN + pos * 16 + i2); }
#pragma unroll
            for (int r = 0; r < 4; ++r) { const int m = m0 + r * ngw2; if (m >= T) continue; bf16* qp = Qm + (size_t)m * BW + (lane2 >> 3) * HD + i2;
                const float a0 = bflo(w1[r]), a1 = bfhi(w1[r]), b0 = bflo(w2[r]), b1 = bfhi(w2[r]);
                *(unsigned*)qp = pk2(a0 * cs[r][0] - b0 * sn[r][0], a1 * cs[r][1] - b1 * sn[r][1]); *(unsigned*)(qp + 16) = pk2(b0 * cs[r][0] + a0 * sn[r][0], b1 * cs[r][1] + a1 * sn[r][1]); } }
        for (int it = ngw2 - 1 - gw2; it < NB * NH * 8; it += ngw2) { const int blk = it & 7, h = (it >> 3) & 7, b = it >> 6; const int rg = lane2 >> 4, c = lane2 & 15;
            bf16* kp = Km + ((size_t)b * SEQ + blk * 256 + rg) * BW + h * HD + 8 * c; float sm[8];
#pragma unroll
            for (int j = 0; j < 8; ++j) sm[j] = 0.f;
            const bool isrot = c < 4; const float sg = (c < 2) ? -1.f : 1.f; const int jr = 8 * (c & 1);
#pragma unroll 1
            for (int i0 = 0; i0 < 64; i0 += 16) { u32x4 kw[16];
#pragma unroll
                for (int u = 0; u < 16; ++u) kw[u] = *(const u32x4*)(kp + (size_t)(4 * (i0 + u)) * BW);
#pragma unroll
                for (int u = 0; u < 16; ++u) { float a[8] = {bflo(kw[u].x), bfhi(kw[u].x), bflo(kw[u].y), bfhi(kw[u].y), bflo(kw[u].z), bfhi(kw[u].z), bflo(kw[u].w), bfhi(kw[u].w)}; float pr[8];
#pragma unroll
                    for (int j = 0; j < 8; ++j) pr[j] = __shfl_xor(a[j], 2);
                    if (isrot) { const int pos = blk * 256 + 4 * (i0 + u) + rg; const f32x4 c0 = *(const f32x4*)(RCOS + pos * 16 + jr), c1 = *(const f32x4*)(RCOS + pos * 16 + jr + 4), s0 = *(const f32x4*)(RSIN + pos * 16 + jr), s1 = *(const f32x4*)(RSIN + pos * 16 + jr + 4);
#pragma unroll
                        for (int j = 0; j < 4; ++j) { a[j] = a[j] * c0[j] + sg * pr[j] * s0[j]; a[4 + j] = a[4 + j] * c1[j] + sg * pr[4 + j] * s1[j]; }
                        u32x4 o; o.x = pk2(a[0], a[1]); o.y = pk2(a[2], a[3]); o.z = pk2(a[4], a[5]); o.w = pk2(a[6], a[7]); *(u32x4*)(kp + (size_t)(4 * (i0 + u)) * BW) = o; }
#pragma unroll
                    for (int j = 0; j < 8; ++j) sm[j] += a[j]; } }
#pragma unroll
            for (int j = 0; j < 8; ++j) { sm[j] += __shfl_xor(sm[j], 16); sm[j] += __shfl_xor(sm[j], 32); }
            if (rg == 0) { float* ko = KMEAN + (size_t)it * HD + 8 * c; *(f32x4*)ko = (f32x4){sm[0], sm[1], sm[2], sm[3]} * (1.0f / 256.0f); *(f32x4*)(ko + 4) = (f32x4){sm[4], sm[5], sm[6], sm[7]} * (1.0f / 256.0f); } }
        if (ov24) {
            asm volatile("s_waitcnt vmcnt(0)" ::: "memory"); __syncthreads();
            if (F.wave == 0 && lane_now() == 0) { __builtin_amdgcn_fence(__ATOMIC_RELEASE, "agent"); asm volatile("s_waitcnt vmcnt(0)" ::: "memory"); (void)xb_add(F.ctl + CW_P2DONE, 1u); }
        }
    }
    if (IN(2) && !ov24 && BOTH(2)) GRID_BAR();


    if (IN(4)) {
    {
        LAS char* alds = (LAS char*)F.lds;
        const float* zero_bias = (const float*)(F.ctl + CW_ZERO);
        if (is_conv) {
            constexpr int I_W1 = 64 * 8, I_W2 = 32 * 8, NIT = NE * I_W1 + NE * I_W2;
            LAS unsigned char* wl = F.lds + F.wave * 9216; const int lnc = lane_now();
            const int cgw = (ngrp ? ((rin >> 3) * CONV_PER8 + cslot) * 8 + cls : (int)blockIdx.x) * NWAVES + F.wave;
            for (int it = cgw; it < NIT; it += nconv * NWAVES) {
                int r = it;
                if (r < NE * I_W1) { const int e = r / I_W1, q = r % I_W1, kb = q >> 6, nb = q & 63; p0_strip<1>(w_mlp1 + (size_t)e * DM * 4096, 4096, 256 * kb, 64 * nb, Wt_1 + (size_t)e * 4096 * DM, DM, 64 * nb, W8_SCALE, lnc, wl); continue; } r -= NE * I_W1;
                { const int e = r / I_W2, q = r % I_W2, kb = q >> 5, nb = q & 31; p0_strip<0>(w_mlp2 + (size_t)e * DFF * DM, DM, 256 * kb, 64 * nb, Wt_2 + (size_t)e * DM * DFF, DFF, 64 * nb, W8_SCALE, lnc, wl); }
            }
            __syncthreads();
        }
        if (ov24) {
            if (F.wave == 0 && lane_now() == 0) { const unsigned need = (unsigned)(F.G - nconv); XB_SPIN(xb_ld(F.ctl + CW_P2DONE) < need, F.ctl + CW_BAR);
                __builtin_amdgcn_fence(__ATOMIC_ACQUIRE, "agent"); asm volatile("s_waitcnt vmcnt(0)" ::: "memory"); }
            __syncthreads();
        }
        auto mkref = [&](int id) -> att::BlockRef {
            const int q = id >> 8, idx = id & 255, bb = idx >> 3, br = bb >> 4, b = bb & 15, h = q, bh = b * NH + h, qb = 7 - (idx & 7);
            att::BlockRef r; const bf16* base = QKV + (size_t)(br * 3) * QKV_STRIDE;
            r.Q = base + ((size_t)b * SEQ + qb * 256) * BW + h * HD; r.K = base + QKV_STRIDE + (size_t)b * SEQ * BW + h * HD; r.V = base + 2 * QKV_STRIDE + (size_t)b * SEQ * BW + h * HD;
            r.O = Ob + ((size_t)b * SEQ + qb * 256) * DM + br * BW + h * HD;
            r.bias = br ? zero_bias : BIAS + (size_t)bh * SEQ; r.sel = br ? SELB + (size_t)bh * SEQ + qb * 256 : nullptr; r.P0 = qb * 256; return r; };
        auto moba_select = [&](int id) {
            const int q = id >> 8, idx = id & 255, bb = idx >> 3, b = bb & 15, h = q, bh = b * NH + h, own = 7 - (idx & 7);
            int ln = lane_now(); asm volatile("" : "+v"(ln));
            const int row = F.wave * 32 + (ln & 31), half = ln >> 5; unsigned bits;
            if (own <= 3) bits = (1u << own) - 1u;
            else { const bf16* qp = QKV + 3 * QKV_STRIDE + ((size_t)b * SEQ + own * 256 + row) * BW + h * HD + 64 * half; const float* km = KMEAN + (size_t)bh * 8 * HD + 64 * half; float gt[7];
#pragma unroll
                for (int n = 0; n < 7; ++n) gt[n] = 0.f;
#pragma unroll 2
                for (int c8 = 0; c8 < 8; ++c8) { const u32x4 qw = *(const u32x4*)(qp + 8 * c8); const float q0 = bflo(qw.x), q1 = bfhi(qw.x), q2 = bflo(qw.y), q3 = bfhi(qw.y), q4 = bflo(qw.z), q5 = bfhi(qw.z), q6 = bflo(qw.w), q7 = bfhi(qw.w);
#pragma unroll
                    for (int n = 0; n < 7; ++n) { const f32x4 ka = *(const f32x4*)(km + n * HD + 8 * c8), kb = *(const f32x4*)(km + n * HD + 8 * c8 + 4);
                        gt[n] += (q0 * ka[0] + q1 * ka[1]) + (q2 * ka[2] + q3 * ka[3]) + (q4 * kb[0] + q5 * kb[1]) + (q6 * kb[2] + q7 * kb[3]); } }
#pragma unroll
                for (int n = 0; n < 7; ++n) gt[n] += __shfl_xor(gt[n], 32);
                bits = 0u;
#pragma unroll
                for (int n = 0; n < 7; ++n) { int rank = 0;
#pragma unroll
                    for (int m = 0; m < 7; ++m) { const bool valid = m < own; const bool better = (gt[m] > gt[n]) || (gt[m] == gt[n] && m < n); rank += (valid && m != n && better) ? 1 : 0; }
                    if (n < own && rank < 3) bits |= 1u << n; } }
            if (half == 0) SELB[(size_t)bh * SEQ + own * 256 + row] = bits;
            VM_WAIT(); };
        auto is_moba = [](int id) -> bool { return (((id & 255) >> 3) >> 4) != 0; };
        auto fetch = [&]() -> int {
            unsigned qo = F.MISC[16];
            while (qo < 8u) { const unsigned q = ((unsigned)cls + qo) & 7u; const unsigned idx = atomicAdd(F.ctl + CW_ATTQ + 64 * q, 1u); if (idx < 256u) { F.MISC[16] = qo; return (int)(q * 256u + idx); } ++qo; }
            F.MISC[16] = 8u; return -1; };
        const bool fetcher = F.wave == 0 && lane_now() == 0;
        if (fetcher) { F.MISC[16] = 0u; const int a0 = fetch(); const int a1 = a0 >= 0 ? fetch() : -1; F.MISC[12] = (unsigned)a0; F.MISC[13] = (unsigned)a1; }
        __syncthreads();
        int cur_id = __builtin_amdgcn_readfirstlane((int)F.MISC[12]), nxt_id = __builtin_amdgcn_readfirstlane((int)F.MISC[13]);
        __syncthreads();
        if (cur_id >= 0) {
            att::BlockRef cur = mkref(cur_id); att::Seam S; int iter = 0;
            if (is_moba(cur_id)) moba_select(cur_id);
            att::attn_prime(cur, alds, S, F.wave);
            for (;;) {
                const bool last = nxt_id < 0;
                const att::BlockRef nxt = last ? cur : mkref(nxt_id);
                if (!last && fetcher) F.MISC[12 + (iter & 1)] = (unsigned)fetch();
                __builtin_amdgcn_sched_barrier(0); if (!last && is_moba(nxt_id)) moba_select(nxt_id); __builtin_amdgcn_sched_barrier(0);
                att::attn_block(cur, nxt, alds, S, F.wave);
                if (last) break;
                cur = nxt; nxt_id = __builtin_amdgcn_readfirstlane((int)F.MISC[12 + (iter & 1)]); ++iter;
            }
        }
    }
        if (BOTH(4)) GRID_BAR();
    }

    if (IN(5)) {
    _Pragma("unroll") for (int rep_ = 0; rep_ <= REP(5); ++rep_) {
        { pg8::Gemm g{DM, DM, DM}; pg8::DenseOrder S; S.init(Ob, Wt_cat, DM, DM, T, DM, F.G, (int)blockIdx.x, 1); S.rep = 1 + REP(20); pg8::EpiGate E{SG, MIX8};
          pg8::gemm_phase<pg8::EpiGate, pg8::DenseOrder, true, false, true>(F.lds, g, S, E, F.wave); }
    if (REP(5) && rep_ == 0) { VM_WAIT(); __syncthreads(); } }
        if (BOTH(5)) GRID_BAR();
    }

    if (IN(6)) {
    _Pragma("unroll") for (int rep_ = 0; rep_ <= REP(6); ++rep_) {
        pg8::Gemm g{DM, DM, DM}; pg8::DenseOrder S; S.init(MIX8, Wt_out, DM, DM, T, DM, F.G, (int)blockIdx.x, 1); S.rep = 1 + REP(21); pg8::EpiResid E{x, X2, HN8, g_ffn};
        pg8::gemm_phase<pg8::EpiResid, pg8::DenseOrder, true, false, true>(F.lds, g, S, E, F.wave);
    if (REP(6) && rep_ == 0) { VM_WAIT(); __syncthreads(); } }
        if (BOTH(6)) GRID_BAR();
    }

    if (IN(7)) {
        const int lane7 = (int)__builtin_amdgcn_mbcnt_hi(~0u, __builtin_amdgcn_mbcnt_lo(~0u, 0u));
        LAS int* lcnt = (LAS int*)(F.lds + TAB_OFF); LAS int* lbase = lcnt + 32;
        for (int wt0 = F.vcu * NWAVES; wt0 < T / 16; wt0 += F.NGW) {
            const int tid7 = F.wave * 64 + lane7;
            if (tid7 < 32) lcnt[tid7] = 0;
            __syncthreads();
            const int row0 = (wt0 + F.wave) * 16, j = lane7 & 15, q = lane7 >> 4;
            const bf16* xrow = X2 + (size_t)(row0 + j) * DM + 8 * q;
            f32x4 acc0 = {0.f, 0.f, 0.f, 0.f}, acc1 = acc0; float ss = 0.f;
#pragma unroll 1
            for (int half = 0; half < 2; ++half) {
                if (half) __syncthreads();
                { const f32x4* src = (const f32x4*)(WR + half * 32768); f32x4 tmp[16];
#pragma unroll
                  for (int u = 0; u < 16; ++u) tmp[u] = src[tid7 + 512 * u];
#pragma unroll
                  for (int u = 0; u < 16; ++u) { const int i = tid7 + 512 * u, cc = i >> 8, ln = (i >> 2) & 63, k4 = i & 3; ((LAS f32x4*)F.lds)[cc * 256 + k4 * 64 + ln] = tmp[u]; } }
                __syncthreads();
                const LAS f32x4* wl = (const LAS f32x4*)F.lds + lane7;
#pragma unroll 4
                for (int c = 0; c < 32; ++c) { const u32x4 xw = *(const u32x4*)(xrow + 32 * (half * 32 + c)); const f32x4 wa = wl[c * 256], wb = wl[c * 256 + 64], wc2 = wl[c * 256 + 128], wd = wl[c * 256 + 192];
                    const float xv[8] = {bflo(xw.x), bfhi(xw.x), bflo(xw.y), bfhi(xw.y), bflo(xw.z), bfhi(xw.z), bflo(xw.w), bfhi(xw.w)};
#pragma unroll
                    for (int s = 0; s < 8; ++s) { ss += xv[s] * xv[s]; acc0 = __builtin_amdgcn_mfma_f32_16x16x4f32(s < 4 ? wa[s] : wb[s - 4], xv[s], acc0, 0, 0, 0); acc1 = __builtin_amdgcn_mfma_f32_16x16x4f32(s < 4 ? wc2[s] : wd[s - 4], xv[s], acc1, 0, 0, 0); } } }
            ss += __shfl_xor(ss, 16); ss += __shfl_xor(ss, 32);
            const float rstd = 1.0f / sqrtf(ss * (1.0f / DM) + RMS_EPS);
            float lg[8]; const f32x4 br0 = *(const f32x4*)(b_router + 4 * q), br1 = *(const f32x4*)(b_router + 16 + 4 * q);
#pragma unroll
            for (int r = 0; r < 4; ++r) { lg[r] = acc0[r] * rstd + br0[r]; lg[4 + r] = acc1[r] * rstd + br1[r]; }
            float tv[4]; int ti[4];
#pragma unroll
            for (int k = 0; k < TOPK; ++k) { float bv = lg[0]; int bi = 4 * q;
#pragma unroll
                for (int r = 1; r < 8; ++r) { const int e = (r < 4) ? 4 * q + r : 16 + 4 * q + (r - 4); if (lg[r] > bv) { bv = lg[r]; bi = e; } }
#pragma unroll
                for (int off = 16; off <= 32; off <<= 1) { const float ov = __shfl_xor(bv, off); const int oi = __shfl_xor(bi, off); if (ov > bv || (ov == bv && oi < bi)) { bv = ov; bi = oi; } }
                tv[k] = bv; ti[k] = bi;
#pragma unroll
                for (int r = 0; r < 8; ++r) { const int e = (r < 4) ? 4 * q + r : 16 + 4 * q + (r - 4); if (e == bi) lg[r] = -__builtin_inff(); } }
            const float e1 = expf(tv[1] - tv[0]), e2 = expf(tv[2] - tv[0]), e3 = expf(tv[3] - tv[0]), inv = 1.0f / (1.0f + e1 + e2 + e3);
            const float gwt[4] = {inv, e1 * inv, e2 * inv, e3 * inv};
            int lr[4] = {0, 0, 0, 0};
            if (q == 0) {
#pragma unroll
                for (int k = 0; k < TOPK; ++k) lr[k] = __hip_atomic_fetch_add(lcnt + ti[k], 1, __ATOMIC_RELAXED, __HIP_MEMORY_SCOPE_WORKGROUP); }
            __syncthreads();
            if (tid7 < 32) lbase[tid7] = (int)__hip_atomic_fetch_add(F.ctl + CW_CNT + 64 * tid7, (unsigned)lcnt[tid7], RLX_AGENT);
            __syncthreads();
            if (q == 0) { const int t = row0 + j;
#pragma unroll
                for (int k = 0; k < TOPK; ++k) { EIDX[t * 4 + k] = ti[k]; EW[t * 4 + k] = gwt[k]; RANK[t * 4 + k] = lbase[ti[k]] + lr[k]; }
                RSTD[t] = rstd; }
            __syncthreads();
        }
        if (BOTH(7)) GRID_BAR();
    }

    LAS int* tab = (LAS int*)(F.lds + TAB_OFF + 512);
    if (hi > 8 && lo <= 10) {
        if (F.wave == 0 && lane_now() == 0) { int acc = 0; for (int e = 0; e < NE; ++e) { tab[e] = acc; const unsigned c = __hip_atomic_load(F.ctl + CW_CNT + 64 * e, RLX_AGENT); acc += (int)((c + 255u) >> 8); } tab[NE] = acc; }
        __syncthreads();
    }

    if (IN(8)) {
    _Pragma("unroll") for (int rep_ = 0; rep_ <= REP(8); ++rep_) {
        const int lane8 = (int)__builtin_amdgcn_mbcnt_hi(~0u, __builtin_amdgcn_mbcnt_lo(~0u, 0u));
        for (int t = F.gw * 64 + lane8; t < T; t += F.NGW * 64) {
            const float rstd = RSTD[t];
#pragma unroll
            for (int k = 0; k < 4; ++k) { const int p = tab[EIDX[t * 4 + k]] * 256 + RANK[t * 4 + k]; POS[t * 4 + k] = p; ROWTOK[p] = t; ROWW[p] = EW[t * 4 + k]; ROWRSTD[p] = rstd; } }
    if (REP(8) && rep_ == 0) { VM_WAIT(); __syncthreads(); } }
        if (BOTH(8)) GRID_BAR();
    }

    if (IN(9)) {
    _Pragma("unroll") for (int rep_ = 0; rep_ <= REP(9); ++rep_) {
        pg8::Gemm g{DM, DM, DM}; pg8::MoeOrder<16, true> S{HN8, Wt_1, DM, DM, tab, F.G, (int)blockIdx.x, 1 + REP(18), ROWTOK}; pg8::EpiSwiglu E{ACT, b_mlp1, ROWRSTD};
        pg8::gemm_phase<pg8::EpiSwiglu, pg8::MoeOrder<16, true>, true, false, true>(F.lds, g, S, E, F.wave);
    if (REP(9) && rep_ == 0) { VM_WAIT(); __syncthreads(); } }
        if (BOTH(9)) GRID_BAR();
    }

    if (IN(10)) {
    _Pragma("unroll") for (int rep_ = 0; rep_ <= REP(10); ++rep_) {
        pg8::Gemm g{DFF, DFF, DFF}; pg8::MoeOrder<8> S{ACT, Wt_2, DFF, DFF, tab, F.G, (int)blockIdx.x, 1 + REP(19)}; pg8::EpiDown E{Yb, b_mlp2, ROWW};
        pg8::gemm_phase<pg8::EpiDown, pg8::MoeOrder<8>, true, false, true>(F.lds, g, S, E, F.wave);
    if (REP(10) && rep_ == 0) { VM_WAIT(); __syncthreads(); } }
        if (BOTH(10)) GRID_BAR();
    }

    if (IN(11)) {
    _Pragma("unroll") for (int rep_ = 0; rep_ <= REP(11); ++rep_) {
        const bool poison = xb_ld(F.ctl + CW_BAR + XB_TMO) != 0u;
        const int lane11 = (int)__builtin_amdgcn_mbcnt_hi(~0u, __builtin_amdgcn_mbcnt_lo(~0u, 0u));
        int posn[4]; u32x2 xn[8];
        { const int t0 = F.gw;
#pragma unroll
          for (int k = 0; k < 4; ++k) posn[k] = POS[t0 * 4 + k];
          const u32x2* xr0 = (const u32x2*)(X2 + (size_t)t0 * DM) + lane11;
#pragma unroll
          for (int j = 0; j < 8; ++j) xn[j] = xr0[64 * j]; }
        for (int t = F.gw; t < T; t += F.NGW) {
            int pos[4]; u32x2 xc[8];
#pragma unroll
            for (int k = 0; k < 4; ++k) pos[k] = posn[k];
#pragma unroll
            for (int j = 0; j < 8; ++j) xc[j] = xn[j];
            unsigned yv[8][4];
#pragma unroll
            for (int j = 0; j < 8; ++j)
#pragma unroll
                for (int k = 0; k < 4; ++k) yv[j][k] = *((const unsigned*)(Yb + (size_t)pos[k] * DM) + lane11 + 64 * j);
            if (t + F.NGW < T) { const int t1 = t + F.NGW;
#pragma unroll
                for (int k = 0; k < 4; ++k) posn[k] = POS[t1 * 4 + k];
                const u32x2* xr1 = (const u32x2*)(X2 + (size_t)t1 * DM) + lane11;
#pragma unroll
                for (int j = 0; j < 8; ++j) xn[j] = xr1[64 * j]; }
            f32x4 v[8]; float ss = 0.f;
#pragma unroll
            for (int j = 0; j < 8; ++j) { v[j] = (f32x4){bflo(xc[j].x), bfhi(xc[j].x), bflo(xc[j].y), bfhi(xc[j].y)};
#pragma unroll
                for (int k = 0; k < 4; ++k) { const unsigned y = yv[j][k]; const f32x2 ylo = __builtin_amdgcn_cvt_pk_f32_fp8(y, false), yhi = __builtin_amdgcn_cvt_pk_f32_fp8(y, true);
                    v[j][0] += ylo[0] * (1.0f / Y8_SCALE); v[j][1] += ylo[1] * (1.0f / Y8_SCALE); v[j][2] += yhi[0] * (1.0f / Y8_SCALE); v[j][3] += yhi[1] * (1.0f / Y8_SCALE); }
                ss += (v[j][0] * v[j][0] + v[j][1] * v[j][1]) + (v[j][2] * v[j][2] + v[j][3] * v[j][3]); }
            float rstd = 1.0f / sqrtf(wave_sum(ss) * (1.0f / DM) + RMS_EPS); if (poison) rstd = __builtin_nanf("");
            f32x4* orow = (f32x4*)(args.out + (size_t)t * DM) + lane11;
#pragma unroll
            for (int j = 0; j < 8; ++j) { const f32x4 g = *((const f32x4*)g_final + lane11 + 64 * j); orow[64 * j] = v[j] * rstd * g; }
        }
    }
    }
#undef IN
#undef BOTH
#undef GRID_BAR
}

constexpr int N_PHASES = 12;
extern "C" void kernel_launch(void* const* d_in, const int* in_sizes, int n_in, void* d_out, int out_size, void* d_ws, size_t ws_size, hipStream_t stream) {
    static int grid = 0;
    if (grid == 0) {
        if (n_in != 15 || in_sizes[0] != T * DM || out_size != T * DM || ws_size < WS_END) { fprintf(stderr, "kernel_launch: unexpected shapes (n_in %d, in0 %d, out %d, ws %zu < %zu); nothing launched\n", n_in, n_in > 0 ? in_sizes[0] : -1, out_size, ws_size, (size_t)WS_END); grid = -1; return; }
        int dev = 0, cus = 0, per_cu = 0;
        if (hipGetDevice(&dev) != hipSuccess || hipDeviceGetAttribute(&cus, hipDeviceAttributeMultiprocessorCount, dev) != hipSuccess) { fprintf(stderr, "kernel_launch: device query failed\n"); grid = -1; return; }
        if (hipFuncSetAttribute((const void*)fwd_kernel, hipFuncAttributeMaxDynamicSharedMemorySize, LDS_BYTES) != hipSuccess) { fprintf(stderr, "kernel_launch: hipFuncSetAttribute failed\n"); grid = -1; return; }
        if (hipOccupancyMaxActiveBlocksPerMultiprocessor(&per_cu, (const void*)fwd_kernel, NWAVES * 64, LDS_BYTES) != hipSuccess || per_cu < 1)
            fprintf(stderr, "kernel_launch: note: occupancy query reports %d workgroups per CU\n", per_cu);
        (void)hipGetLastError();
        grid = cus;
    }
    if (grid < 0) return;
    if (hipMemsetAsync((char*)d_ws + WS_CTL, 0, CTL_ZERO_BYTES, stream) != hipSuccess) { fprintf(stderr, "kernel_launch: memset failed\n"); return; }
    Args a{};
    for (int i = 0; i < 15; ++i) a.in[i] = (const float*)d_in[i];
    a.out = (float*)d_out; a.ws = (unsigned char*)d_ws;
#if MK_PER_PHASE
    for (int p = 0; p < N_PHASES; ++p) { a.ph_lo = p; a.ph_hi = p + 1; hipLaunchKernelGGL(fwd_kernel, dim3(grid), dim3(NWAVES * 64), LDS_BYTES, stream, a); }
#else
    a.ph_lo = 0; a.ph_hi = N_PHASES;
    hipLaunchKernelGGL(fwd_kernel, dim3(grid), dim3(NWAVES * 64), LDS_BYTES, stream, a);
#endif
    const hipError_t le = hipPeekAtLastError();
    if (le != hipSuccess) fprintf(stderr, "kernel_launch: launch failed: %s\n", hipGetErrorName(le));
}
```

```cpp
#include <hip/hip_runtime.h>
#include <cstdio>
#include <cstdint>

#ifndef REPEAT_MASK
#define REPEAT_MASK 0
#endif
#define REP(k) ((REPEAT_MASK >> (k)) & 1)
#ifndef MK_PER_PHASE
#define MK_PER_PHASE 0
#endif

#define GAS __attribute__((address_space(1)))
#define LAS __attribute__((address_space(3)))
typedef unsigned short bf16;
typedef short bf16x8 __attribute__((ext_vector_type(8)));
typedef short s16x4 __attribute__((ext_vector_type(4)));
typedef float f32x2 __attribute__((ext_vector_type(2)));
typedef float f32x4 __attribute__((ext_vector_type(4)));
typedef float f32x16 __attribute__((ext_vector_type(16)));
typedef unsigned u32x2 __attribute__((ext_vector_type(2)));
typedef unsigned u32x4 __attribute__((ext_vector_type(4)));
typedef GAS unsigned gu32;

constexpr int NB = 16, SEQ = 2048, DM = 2048, T = NB * SEQ;
constexpr int NH = 8, HD = 128, BW = NH * HD;
constexpr int IN_COLS = 10248, FL_COL = 3072;
constexpr int NV_IN = 10240;
constexpr int NE = 32, TOPK = 4, DFF = 2048;
constexpr int CAPE = T;
constexpr int ROWS_MAX = T * TOPK + NE * 256;
constexpr float RMS_EPS = 1e-5f;
constexpr float SW_ALPHA = 1.702f, SW_LIMIT = 7.0f;
constexpr float W8_SCALE = 64.0f, ACT8_SCALE = 4.0f, Y8_SCALE = 32.0f, MIX8_SCALE = 64.0f, O8_SCALE = 16.0f;

constexpr size_t MiB = 1u << 20;
constexpr size_t WS_CTL = 0, CTL_ZERO_BYTES = 1 * MiB;
constexpr size_t WS_WIN = 1 * MiB;
constexpr size_t WS_WFOX = WS_WIN + 40 * MiB;
constexpr size_t WS_WMOBA = WS_WFOX + 4 * MiB;
constexpr size_t WS_WOUT = WS_WMOBA + 4 * MiB;
constexpr size_t WS_W1 = WS_WOUT + 8 * MiB;
constexpr size_t WS_W2 = WS_W1 + 512 * MiB;
constexpr size_t WS_WR = WS_W2 + 256 * MiB;
constexpr size_t WS_ROPE = WS_WR + 1 * MiB;
constexpr size_t WS_LOGF = WS_ROPE + 1 * MiB;
constexpr size_t WS_BIAS = WS_LOGF + 1 * MiB;
constexpr size_t WS_KMEAN = WS_BIAS + 1 * MiB;
constexpr size_t WS_SELB = WS_KMEAN + 1 * MiB;
constexpr size_t WS_EIDX = WS_SELB + 1 * MiB;
constexpr size_t WS_EW = WS_EIDX + 512 * 1024;
constexpr size_t WS_RANK = WS_EW + 512 * 1024;
constexpr size_t WS_POS = WS_RANK + 512 * 1024;
constexpr size_t WS_RSTD = WS_POS + 512 * 1024;
constexpr size_t WS_ROWW = WS_RSTD + 1 * MiB;
constexpr size_t WS_H = WS_ROWW + 1 * MiB;
constexpr size_t WS_QKV = WS_H + 128 * MiB;
constexpr size_t QKV_STRIDE = (size_t)T * BW;
constexpr size_t WS_SG = WS_QKV + 384 * MiB;
constexpr size_t WS_O = WS_SG + 256 * MiB;
constexpr size_t WS_MIX = WS_O + 128 * MiB;
constexpr size_t WS_X2 = WS_MIX + 128 * MiB;
constexpr size_t WS_AS = WS_X2 + 256 * MiB;
constexpr size_t WS_ACT = WS_AS + 544 * MiB;
constexpr size_t WS_Y = WS_ACT + 544 * MiB;
constexpr size_t WS_END = WS_Y + 544 * MiB;
static_assert((size_t)ROWS_MAX * DM * 2 <= 544 * MiB, "row buffers");
constexpr int CW_TMO = 0, CW_CODE = 1;
constexpr int CW_BAR = 4096;
constexpr int CW_CNT = 8192;
constexpr int CW_P2DONE = 11264;
constexpr int CW_ATTQ = 12288;
constexpr int CONV_PER8 = 2;
constexpr int CW_ZERO = 16384;

constexpr int RING_BYTES = 131072;
constexpr int LDSCTL_OFF = RING_BYTES, MISC_OFF = LDSCTL_OFF + 320;
constexpr int TAB_OFF = LDSCTL_OFF + 1024;
constexpr int LDS_BYTES = 147456;
constexpr int NWAVES = 8;

#define RLX_AGENT __ATOMIC_RELAXED, __HIP_MEMORY_SCOPE_AGENT
#define LDS_WAIT() asm volatile("s_waitcnt lgkmcnt(0)" ::: "memory")
#define VM_WAIT() asm volatile("s_waitcnt vmcnt(0)" ::: "memory")
__device__ __forceinline__ unsigned f2bf(float f) { unsigned u = __builtin_bit_cast(unsigned, f); return (u + 0x7fffu + ((u >> 16) & 1u)) >> 16; }
__device__ __forceinline__ unsigned pk2(float lo, float hi) { return f2bf(lo) | (f2bf(hi) << 16); }
__device__ __forceinline__ float bflo(unsigned w) { return __builtin_bit_cast(float, w << 16); }
__device__ __forceinline__ float bfhi(unsigned w) { return __builtin_bit_cast(float, w & 0xffff0000u); }
typedef __bf16 bf16x2_t __attribute__((ext_vector_type(2)));
__device__ __forceinline__ unsigned cvt_pk_bf16(float lo, float hi) { f32x2 v = {lo, hi}; bf16x2_t b = __builtin_convertvector(v, bf16x2_t); return __builtin_bit_cast(unsigned, b); }
__device__ __forceinline__ unsigned pk4_fp8(float a, float b, float c, float d) { unsigned w = 0; w = __builtin_amdgcn_cvt_pk_fp8_f32(a, b, w, false); w = __builtin_amdgcn_cvt_pk_fp8_f32(c, d, w, true); return w; }
__device__ __forceinline__ int lane_now() { return (int)__builtin_amdgcn_mbcnt_hi(~0u, __builtin_amdgcn_mbcnt_lo(~0u, 0u)); }
__device__ __forceinline__ float sat8(float v) { return __builtin_amdgcn_fmed3f(v, -448.0f, 448.0f); }
__device__ __forceinline__ float wave_sum(float v) {
#pragma unroll
    for (int o = 1; o < 64; o <<= 1) v += __shfl_xor(v, o);
    return v;
}
__device__ __forceinline__ float sigmoidf_fast(float z) { return __builtin_amdgcn_rcpf(1.0f + __builtin_amdgcn_exp2f(-1.4426950408889634f * z)); }

namespace pg8 {
constexpr int BM = 256, BK = 64, HALF = 128, HTB = HALF * BK * 2, STAGE_BYTES = 8 * HTB, NXCD = 8, WGM = 4;
__host__ __device__ __forceinline__ int lds_byte(int r, int c) { const int st = (r >> 4) * 2 + (c >> 5), rr = r & 15, cc = c & 31, ob = rr * 64 + cc * 2; return st * 1024 + (ob ^ (((ob >> 9) & 1) << 5)); }
__host__ __device__ __forceinline__ void stage_rc(int b, int& R, int& C) { const int st = b / 1024, sb = b % 1024, swz = sb ^ (((sb >> 9) & 1) << 5); R = (st >> 1) * 16 + swz / 64; C = (st & 1) * 32 + (swz % 64) / 2; }
__host__ __device__ __forceinline__ int perm32(int rho) { const int n = rho >> 4, i = rho & 15; return 8 * (i >> 2) + 4 * n + (i & 3); }
__host__ __device__ __forceinline__ int perm256(int R) { return 64 * (R >> 5) + 16 * ((R & 15) >> 2) + 4 * ((R >> 4) & 1) + (R & 3); }

struct Unit { int pm, pn, e, rb; };
struct Gemm { int KB, ldaB, ldbB; };

struct DenseOrder {
    static constexpr bool GATHER = false;
    __device__ __forceinline__ int row_src(const Unit&, int) const { return 0; }
    const bf16* A; const bf16* Bt; int lda, ldb;
    int nM, nN, nwg, G, c; int abytes, bbytes; int rep = 1;
    __device__ __forceinline__ void init(const void* A_, const void* Bt_, int lda_, int ldb_, int M, int N, int G_, int c_, int elt = 2) { A = (const bf16*)A_; Bt = (const bf16*)Bt_; lda = lda_ * elt; ldb = ldb_ * elt; nM = M / BM; nN = N / BM; nwg = nM * nN; G = G_; c = c_;
        abytes = M * lda; bbytes = N * ldb; }
    __device__ __forceinline__ bool next(int i, Unit& u) const {
        long L = (long)i * G + c; if (L >= (long)nwg * rep) return false;
        if (L >= nwg) L -= nwg;
        int wgid = (int)L; { const int q = nwg / NXCD, r = nwg % NXCD, xcd = wgid % NXCD, off = wgid / NXCD; wgid = (xcd < r ? xcd * (q + 1) : r * (q + 1) + (xcd - r) * q) + off; }
        const int nig = WGM * nN, gid = wgid / nig, fm = gid * WGM, gsz = (nM - fm) < WGM ? (nM - fm) : WGM;
        u.pm = fm + ((wgid % nig) % gsz); u.pn = (wgid % nig) / gsz; u.e = 0; u.rb = 0; return true;
    }
    __device__ __forceinline__ const void* a_base() const { return A; }
    __device__ __forceinline__ const void* b_base() const { return Bt; }
    __device__ __forceinline__ int a_bytes() const { return abytes; }
    __device__ __forceinline__ int b_bytes() const { return bbytes; }
    __device__ __forceinline__ unsigned a_off(const Unit& u) const { return (unsigned)u.pm * (unsigned)(BM * lda); }
    __device__ __forceinline__ unsigned b_off(const Unit& u) const { return (unsigned)u.pn * (unsigned)(BM * ldb); }
    __device__ __forceinline__ void a_ready(const Unit&) const {}
    __device__ __forceinline__ void done(const Unit&) const {}
};
template <int NCT, bool GATH = false> struct MoeOrder {
    static constexpr bool GATHER = GATH;
    const unsigned char* A; const unsigned char* Bt; int lda, ldb; const LAS int* tab; int G, c; int rep; const int* rowtok;
    __device__ __forceinline__ int row_src(const Unit& u, int r) const { return rowtok[u.rb + r]; }
    __device__ __forceinline__ bool next(int i, Unit& u) const {
        int L = i * G + c; const int total = tab[NE] * NCT; if (L >= total * rep) return false; if (L >= total) L -= total;
        int e = 0;
#pragma unroll 1
        for (int s = 16; s >= 1; s >>= 1) { if (tab[e + s] * NCT <= L) e += s; }
        const int j = L - tab[e] * NCT, x = j & 7, qq = j >> 3;
        int rt, ct; const int nt = tab[e + 1] - tab[e];
        if (NCT == 16) { const int g8 = nt >> 3;
            if (qq < 16 * g8) { const int g = qq >> 4, q2 = qq & 15; rt = 8 * g + 4 * (x >> 2) + (q2 >> 2); ct = 4 * (x & 3) + (q2 & 3); }
            else { const int lr = qq - 16 * g8; rt = 8 * g8 + (lr >> 1); ct = 2 * x + (lr & 1); } }
        else { const int g4 = nt >> 2;
            if (qq < 4 * g4) { const int g = qq >> 2, q2 = qq & 3; rt = 4 * g + 2 * (x >> 2) + (q2 >> 1); ct = 2 * (x & 3) + (q2 & 1); }
            else { const int lr = qq - 4 * g4; rt = 4 * g4 + lr; ct = x; } }
        u.pm = tab[e] + rt; u.pn = ct; u.e = e; u.rb = e * CAPE + rt * BM; return true;
    }
    __device__ __forceinline__ const void* a_base() const { return A; }
    __device__ __forceinline__ const void* b_base() const { return Bt; }
    __device__ __forceinline__ int a_bytes() const { return (GATH ? T : ROWS_MAX) * lda; }
    __device__ __forceinline__ int b_bytes() const { return NE * NCT * BM * ldb; }
    __device__ __forceinline__ unsigned a_off(const Unit& u) const { return GATH ? 0u : (unsigned)u.pm * (unsigned)(BM * lda); }
    __device__ __forceinline__ unsigned b_off(const Unit& u) const { return (unsigned)(u.e * NCT + u.pn) * (unsigned)(BM * ldb); }
    __device__ __forceinline__ void a_ready(const Unit&) const {}
    __device__ __forceinline__ void done(const Unit&) const {}
};

typedef int i32x4 __attribute__((ext_vector_type(4)));
typedef int i32x8 __attribute__((ext_vector_type(8)));
__device__ __forceinline__ i32x8 cat8(bf16x8 a, bf16x8 b) { const i32x4 x = __builtin_bit_cast(i32x4, a), y = __builtin_bit_cast(i32x4, b); return __builtin_shufflevector(x, y, 0, 1, 2, 3, 4, 5, 6, 7); }
template <class Epi, class Sched, bool ALIGN_EPI, bool SP2, bool FP8 = false>
__device__ __forceinline__ void gemm_phase(LAS unsigned char* lds, const Gemm g, const Sched& S, const Epi& E, int wave) {
    const int wid = wave, lane = lane_now(), tid = wid * 64 + lane, wr = wid >> 2, wc = wid & 3, fr = lane & 15, fq = lane >> 4;
    const int nt = g.KB / (BK * 2);
    unsigned voffA[2][2], voffN[2][2], voffB[2], voffS[2];
#pragma unroll
    for (int i = 0; i < 2; ++i) { int R, C; stage_rc(tid * 16 + i * 8192, R, C); const int Rb = Epi::PERM ? perm256(R) : R;
        voffS[i] = (unsigned)(R * g.ldaB + C * 2); voffB[i] = (unsigned)(Rb * g.ldbB + C * 2); }
#define PG8_VOFF(dst, u) do { if constexpr (Sched::GATHER) { int t_ = lane_now(); asm volatile("" : "+v"(t_)); t_ += wid * 64;        \
        _Pragma("unroll") for (int i_ = 0; i_ < 2; ++i_) { int R_, C_; stage_rc(t_ * 16 + i_ * 8192, R_, C_); \
        _Pragma("unroll") for (int h_ = 0; h_ < 2; ++h_) dst[h_][i_] = (unsigned)S.row_src(u, h_ * HALF + R_) * (unsigned)g.ldaB + (unsigned)(C_ * 2); } } } while (0)
    const unsigned kstep = (unsigned)(BK * 2);
    const unsigned hstepA = Sched::GATHER ? 0u : (unsigned)(HALF * g.ldaB), hstepB = (unsigned)((Epi::PERM ? 8 : HALF) * g.ldbB);
    const __amdgpu_buffer_rsrc_t rsA = __builtin_amdgcn_make_buffer_rsrc((void*)S.a_base(), (short)0, S.a_bytes(), 0x00020000);
    const __amdgpu_buffer_rsrc_t rsB = __builtin_amdgcn_make_buffer_rsrc((void*)S.b_base(), (short)0, S.b_bytes(), 0x00020000);
    const unsigned ldsw = (unsigned)wid * 1024u;
    const int aoff = lds_byte(wr * 64 + fr, fq * 8); int boff = lds_byte(wc * 32 + fr, fq * 8) + 4 * HTB;
    asm volatile("" : "+v"(boff));
#define PG8_SA(b, h) (((b) * 2 + (h)) * HTB)
#define PG8_SB(b, h) ((4 + (b) * 2 + (h)) * HTB)
#define PG8_STAGEX(bufoff, rs, soff, voff) do { _Pragma("unroll") for (int _i = 0; _i < 2; ++_i) \
        __builtin_amdgcn_raw_ptr_buffer_load_lds(rs, (LAS unsigned*)(lds + (bufoff) + ldsw + _i * 8192), 16, (voff)[_i], (soff), 0, 0); } while (0)
#define PG8_STAGE(bufoff, gbase, voff) PG8_STAGE_##voff(bufoff, gbase)
#define PG8_STAGE_voffA(bufoff, soff) do { if constexpr (Sched::GATHER) PG8_STAGEX(bufoff, rsA, soff, voffA[((bufoff) / HTB) & 1]); else PG8_STAGEX(bufoff, rsA, soff, voffS); } while (0)
#define PG8_STAGE_voffX(bufoff, soff) do { if constexpr (Sched::GATHER) { const unsigned vx_[2] = {lastx ? voffN[((bufoff) / HTB) & 1][0] : voffA[((bufoff) / HTB) & 1][0], lastx ? voffN[((bufoff) / HTB) & 1][1] : voffA[((bufoff) / HTB) & 1][1]}; \
        PG8_STAGEX(bufoff, rsA, soff, vx_); } else PG8_STAGEX(bufoff, rsA, soff, voffS); } while (0)
#define PG8_STAGE_voffB(bufoff, soff) PG8_STAGEX(bufoff, rsB, soff, voffB)
#define PG8_LD8(off) __builtin_shufflevector(*(const LAS i32x4*)(lds + (off)), *(const LAS i32x4*)(lds + (off) + 1024), 0, 1, 2, 3, 4, 5, 6, 7)
#define PG8_LDA(dst, b, h) do { _Pragma("unroll") for (int m = 0; m < 4; ++m) { if constexpr (FP8) dst##8[m] = PG8_LD8(PG8_SA(b, h) + aoff + m * 2048); \
        else { _Pragma("unroll") for (int k = 0; k < 2; ++k) dst[m][k] = *(const LAS bf16x8*)(lds + PG8_SA(b, h) + aoff + m * 2048 + k * 1024); } } } while (0)
#define PG8_SBR(b, h) (((b) * 2 + (h)) * HTB)
#define PG8_LDB(dst, b, h) do { _Pragma("unroll") for (int n = 0; n < 2; ++n) { if constexpr (FP8) dst##8[n] = PG8_LD8(PG8_SBR(b, h) + boff + n * 2048); \
        else { _Pragma("unroll") for (int k = 0; k < 2; ++k) dst[n][k] = *(const LAS bf16x8*)(lds + PG8_SBR(b, h) + boff + n * 2048 + k * 1024); } } } while (0)
#define PG8_MMA(ai, bj, At, Bt) do { __builtin_amdgcn_s_setprio(1); _Pragma("unroll") for (int m = 0; m < 4; ++m) _Pragma("unroll") for (int n = 0; n < 2; ++n) { \
        if constexpr (FP8) acc[ai][bj][m][n] = __builtin_amdgcn_mfma_scale_f32_16x16x128_f8f6f4(Bt##8[n], At##8[m], acc[ai][bj][m][n], 0, 0, 0, 0, 0, 0); \
        else { _Pragma("unroll") for (int k = 0; k < 2; ++k) acc[ai][bj][m][n] = __builtin_amdgcn_mfma_f32_16x16x32_bf16(Bt[n][k], At[m][k], acc[ai][bj][m][n], 0, 0, 0); } } \
        __builtin_amdgcn_s_setprio(0); } while (0)
#define PG8_WAIT_V(n) asm volatile("s_waitcnt vmcnt(" #n ")" ::: "memory")
#define PG8_WAIT_L(n) asm volatile("s_waitcnt lgkmcnt(" #n ")" ::: "memory")
#define PG8_BAR __builtin_amdgcn_s_barrier()
#define PG8_SCHED __builtin_amdgcn_sched_barrier(0)
    Unit cur, nxt; int ui = 0;
    if (!S.next(0, cur)) return;
    f32x4 acc[2][2][4][2];
#pragma unroll
    for (int a = 0; a < 2; ++a)
#pragma unroll
        for (int b = 0; b < 2; ++b)
#pragma unroll
            for (int m = 0; m < 4; ++m)
#pragma unroll
                for (int n = 0; n < 2; ++n) acc[a][b][m][n] = (f32x4){0.f, 0.f, 0.f, 0.f};
    bf16x8 At[4][2], B0[2][2], B1[2][2]; i32x8 At8[4], B08[2], B18[2];
    unsigned cA = S.a_off(cur), cB = S.b_off(cur);
    PG8_VOFF(voffA, cur);
    S.a_ready(cur);
    if constexpr (SP2) {
        PG8_STAGE(PG8_SB(0, 0), cB, voffB); PG8_STAGE(PG8_SB(0, 1), cB + hstepB, voffB); PG8_STAGE(PG8_SA(0, 0), cA, voffA); PG8_STAGE(PG8_SA(0, 1), cA + hstepA, voffA);
        if (wr == 1) PG8_BAR;
        PG8_WAIT_V(2); PG8_BAR;
        PG8_STAGE(PG8_SB(1, 0), cB + kstep, voffB); PG8_STAGE(PG8_SA(1, 0), cA + kstep, voffA); PG8_STAGE(PG8_SB(1, 1), cB + hstepB + kstep, voffB);
        PG8_WAIT_V(6); PG8_BAR;
    } else {
        PG8_STAGE(PG8_SB(0, 0), cB, voffB); PG8_STAGE(PG8_SA(0, 0), cA, voffA); PG8_STAGE(PG8_SB(0, 1), cB + hstepB, voffB); PG8_STAGE(PG8_SA(0, 1), cA + hstepA, voffA);
        if (wr == 1) PG8_BAR;
        PG8_WAIT_V(4); PG8_BAR;
        PG8_STAGE(PG8_SB(1, 0), cB + kstep, voffB); PG8_STAGE(PG8_SA(1, 0), cA + kstep, voffA); PG8_STAGE(PG8_SB(1, 1), cB + hstepB + kstep, voffB);
        PG8_WAIT_V(6); PG8_BAR;
    }
    for (;;) {
        const bool has_next = S.next(ui + 1, nxt);
        const unsigned nA = has_next ? S.a_off(nxt) : cA, nB = has_next ? S.b_off(nxt) : cB;
        if constexpr (Sched::GATHER) { if (has_next) PG8_VOFF(voffN, nxt); else {
#pragma unroll
            for (int h_ = 0; h_ < 2; ++h_) { voffN[h_][0] = voffA[h_][0]; voffN[h_][1] = voffA[h_][1]; } } }
#pragma unroll 1
        for (int t = 0; t < nt; t += 2) {
            const bool last = (t == nt - 2);
            const bool lastx = last;
            const unsigned a1 = cA + (unsigned)(t + 1) * kstep;
            const unsigned a2 = last ? nA : cA + (unsigned)(t + 2) * kstep, b2 = last ? nB : cB + (unsigned)(t + 2) * kstep;
            const unsigned a3 = a2 + kstep, b3 = b2 + kstep;
            if (last && has_next) S.a_ready(nxt);
            if constexpr (Epi::HAS_MID) { if (t == nt / 2) { int lm_ = lane_now(); asm volatile("" : "+v"(lm_)); E.mid(acc, cur, wr, wc, lm_ & 15, lm_ >> 4); } }
            if constexpr (SP2) {
            PG8_LDB(B0, 0, 0); PG8_LDB(B1, 0, 1); PG8_SCHED; PG8_LDA(At, 0, 0); PG8_STAGE(PG8_SA(1, 1), a1 + hstepA, voffA);
            PG8_WAIT_V(8); PG8_WAIT_L(0); PG8_BAR; PG8_MMA(0, 0, At, B0); PG8_MMA(0, 1, At, B1); PG8_BAR; PG8_SCHED;
            PG8_LDA(At, 0, 1); PG8_STAGE(PG8_SB(0, 0), b2, voffB); PG8_STAGE(PG8_SB(0, 1), b2 + hstepB, voffB); PG8_STAGE(PG8_SA(0, 0), a2, voffX);
            PG8_WAIT_V(8); PG8_WAIT_L(0); PG8_BAR; PG8_MMA(1, 0, At, B0); PG8_MMA(1, 1, At, B1); PG8_BAR; PG8_SCHED;
            PG8_LDB(B0, 1, 0); PG8_LDB(B1, 1, 1); PG8_SCHED; PG8_LDA(At, 1, 0); PG8_STAGE(PG8_SA(0, 1), a2 + hstepA, voffX);
            PG8_WAIT_V(8); PG8_WAIT_L(0); PG8_BAR; PG8_MMA(0, 0, At, B0); PG8_MMA(0, 1, At, B1); PG8_BAR; PG8_SCHED;
            PG8_LDA(At, 1, 1); PG8_STAGE(PG8_SB(1, 0), b3, voffB); PG8_STAGE(PG8_SB(1, 1), b3 + hstepB, voffB); PG8_STAGE(PG8_SA(1, 0), a3, voffX);
            PG8_WAIT_V(8); PG8_WAIT_L(0); PG8_BAR; PG8_MMA(1, 0, At, B0); PG8_MMA(1, 1, At, B1); PG8_BAR; PG8_SCHED;
            } else {
            PG8_LDB(B0, 0, 0); PG8_SCHED; PG8_LDA(At, 0, 0); PG8_STAGE(PG8_SA(1, 1), a1 + hstepA, voffA);
            PG8_WAIT_L(8); PG8_BAR; PG8_WAIT_L(0); PG8_MMA(0, 0, At, B0); PG8_BAR; PG8_SCHED;
            PG8_LDB(B1, 0, 1); PG8_STAGE(PG8_SB(0, 0), b2, voffB);
            PG8_BAR; PG8_WAIT_L(0); PG8_MMA(0, 1, At, B1); PG8_BAR;
            PG8_LDA(At, 0, 1); PG8_STAGE(PG8_SA(0, 0), a2, voffX);
            PG8_BAR; PG8_WAIT_L(0); PG8_MMA(1, 0, At, B0); PG8_BAR; PG8_SCHED;
            PG8_STAGE(PG8_SB(0, 1), b2 + hstepB, voffB);
            PG8_WAIT_V(6); PG8_BAR; PG8_MMA(1, 1, At, B1); PG8_BAR;
            PG8_LDB(B0, 1, 0); PG8_SCHED; PG8_LDA(At, 1, 0); PG8_STAGE(PG8_SA(0, 1), a2 + hstepA, voffX);
            PG8_WAIT_L(8); PG8_BAR; PG8_WAIT_L(0); PG8_MMA(0, 0, At, B0); PG8_BAR; PG8_SCHED;
            PG8_LDB(B1, 1, 1); PG8_STAGE(PG8_SB(1, 0), b3, voffB);
            PG8_BAR; PG8_WAIT_L(0); PG8_MMA(0, 1, At, B1); PG8_BAR;
            PG8_LDA(At, 1, 1); PG8_STAGE(PG8_SA(1, 0), a3, voffX);
            PG8_BAR; PG8_WAIT_L(0); PG8_MMA(1, 0, At, B0); PG8_BAR; PG8_SCHED;
            PG8_STAGE(PG8_SB(1, 1), b3 + hstepB, voffB);
            PG8_WAIT_V(6); PG8_BAR; PG8_MMA(1, 1, At, B1); PG8_BAR;
            }
        }
        if constexpr (ALIGN_EPI) { if (wr == 0) PG8_BAR; }
        { int le_ = lane_now(); asm volatile("" : "+v"(le_));
          E(acc, cur, wr, wc, le_ & 15, le_ >> 4); } S.done(cur);
        if (!has_next) break;
#pragma unroll
        for (int a = 0; a < 2; ++a)
#pragma unroll
            for (int b = 0; b < 2; ++b)
#pragma unroll
                for (int m = 0; m < 4; ++m)
#pragma unroll
                    for (int n = 0; n < 2; ++n) acc[a][b][m][n] = (f32x4){0.f, 0.f, 0.f, 0.f};
        cur = nxt; cA = nA; cB = nB; ++ui;
        if constexpr (Sched::GATHER) {
#pragma unroll
            for (int h_ = 0; h_ < 2; ++h_) { voffA[h_][0] = voffN[h_][0]; voffA[h_][1] = voffN[h_][1]; } }
        if constexpr (ALIGN_EPI) { if (wr == 1) PG8_BAR; }
    }
    PG8_WAIT_V(0);
    if constexpr (!ALIGN_EPI) { if (wr == 0) PG8_BAR; }
    PG8_BAR;
#undef PG8_SA
#undef PG8_SB
#undef PG8_SBR
#undef PG8_STAGE
#undef PG8_STAGEX
#undef PG8_STAGE_voffA
#undef PG8_STAGE_voffX
#undef PG8_VOFF
#undef PG8_STAGE_voffB
#undef PG8_LDA
#undef PG8_LD8
#undef PG8_LDB
#undef PG8_MMA
#undef PG8_WAIT_V
#undef PG8_WAIT_L
#undef PG8_BAR
#undef PG8_SCHED
}

struct EpiInProj {
    static constexpr bool PERM = true, HAS_MID = false;
    bf16* QKV; bf16* SG;
    static constexpr float DS = 1.0f / W8_SCALE;
    __device__ __forceinline__ void operator()(const f32x4 (&acc)[2][2][4][2], const Unit& u, int wr, int wc, int fr, int fq) const {
        const int row0 = u.pm * BM + wr * 64 + fr;
        if (u.pn < 24) {
            const int t = u.pn >> 2; bf16* base = QKV + (size_t)t * QKV_STRIDE; const int col0 = (u.pn & 3) * BM + wc * 64 + 16 * fq;
#pragma unroll
            for (int ai = 0; ai < 2; ++ai)
#pragma unroll
                for (int m = 0; m < 4; ++m) { const int row = row0 + ai * HALF + m * 16; bf16* rowp = base + (size_t)row * BW + col0;
#pragma unroll
                    for (int bj = 0; bj < 2; ++bj) { const f32x4 v0 = acc[ai][bj][m][0] * DS, v1 = acc[ai][bj][m][1] * DS;
                        u32x4 w; w.x = cvt_pk_bf16(v0[0], v0[1]); w.y = cvt_pk_bf16(v0[2], v0[3]); w.z = cvt_pk_bf16(v1[0], v1[1]); w.w = cvt_pk_bf16(v1[2], v1[3]);
                        *(u32x4*)(rowp + bj * 8) = w; } }
        } else {
            const int col0 = (u.pn - 24) * BM + wc * 64 + 16 * fq;
#pragma unroll
            for (int ai = 0; ai < 2; ++ai)
#pragma unroll
                for (int m = 0; m < 4; ++m) { const int row = row0 + ai * HALF + m * 16; bf16* rowp = SG + (size_t)row * 4096 + col0;
#pragma unroll
                    for (int bj = 0; bj < 2; ++bj) {
                        const f32x4 e0 = acc[ai][bj][m][0] * (-DS * 1.4426950408889634f), e1 = acc[ai][bj][m][1] * (-DS * 1.4426950408889634f);
                        const f32x4 d0 = (f32x4){__builtin_amdgcn_exp2f(e0[0]), __builtin_amdgcn_exp2f(e0[1]), __builtin_amdgcn_exp2f(e0[2]), __builtin_amdgcn_exp2f(e0[3])} + 1.0f;
                        const f32x4 d1 = (f32x4){__builtin_amdgcn_exp2f(e1[0]), __builtin_amdgcn_exp2f(e1[1]), __builtin_amdgcn_exp2f(e1[2]), __builtin_amdgcn_exp2f(e1[3])} + 1.0f;
                        u32x4 w; w.x = cvt_pk_bf16(__builtin_amdgcn_rcpf(d0[0]), __builtin_amdgcn_rcpf(d0[1])); w.y = cvt_pk_bf16(__builtin_amdgcn_rcpf(d0[2]), __builtin_amdgcn_rcpf(d0[3]));
                        w.z = cvt_pk_bf16(__builtin_amdgcn_rcpf(d1[0]), __builtin_amdgcn_rcpf(d1[1])); w.w = cvt_pk_bf16(__builtin_amdgcn_rcpf(d1[2]), __builtin_amdgcn_rcpf(d1[3]));
                        *(u32x4*)(rowp + bj * 8) = w; }
                    asm volatile("" ::: "memory"); }
        }
    }
};
struct EpiGate {
    static constexpr bool PERM = true, HAS_MID = true;
    const bf16* SG; unsigned char* MIX8;
    __device__ __forceinline__ void mid(f32x4 (&acc)[2][2][4][2], const Unit& u, int wr, int wc, int fr, int fq) const {
        const int row0 = u.pm * BM + wr * 64 + fr, col0 = u.pn * BM + wc * 64 + 16 * fq;
#pragma unroll
        for (int ai = 0; ai < 2; ++ai)
#pragma unroll
        for (int mh = 0; mh < 2; ++mh) { u32x4 ga[2][2], gb[2][2];
#pragma unroll
            for (int mm = 0; mm < 2; ++mm) { const int row = row0 + ai * HALF + (2 * mh + mm) * 16;
#pragma unroll
                for (int bj = 0; bj < 2; ++bj) { ga[mm][bj] = *(const u32x4*)(SG + (size_t)row * 4096 + col0 + bj * 8); gb[mm][bj] = *(const u32x4*)(SG + (size_t)row * 4096 + DM + col0 + bj * 8); } }
#pragma unroll
            for (int mm = 0; mm < 2; ++mm) { const int m = 2 * mh + mm;
#pragma unroll
                for (int bj = 0; bj < 2; ++bj) { const u32x4 a = ga[mm][bj], b = gb[mm][bj];
                    const f32x4 r0 = {bflo(a.x) * __builtin_amdgcn_rcpf(bflo(b.x)), bfhi(a.x) * __builtin_amdgcn_rcpf(bfhi(b.x)), bflo(a.y) * __builtin_amdgcn_rcpf(bflo(b.y)), bfhi(a.y) * __builtin_amdgcn_rcpf(bfhi(b.y))};
                    const f32x4 r1 = {bflo(a.z) * __builtin_amdgcn_rcpf(bflo(b.z)), bfhi(a.z) * __builtin_amdgcn_rcpf(bfhi(b.z)), bflo(a.w) * __builtin_amdgcn_rcpf(bflo(b.w)), bfhi(a.w) * __builtin_amdgcn_rcpf(bfhi(b.w))};
                    acc[ai][bj][m][0] = acc[ai][bj][m][0] * r0; acc[ai][bj][m][1] = acc[ai][bj][m][1] * r1; } }
            asm volatile("" ::: "memory"); }
    }
    __device__ __forceinline__ void operator()(const f32x4 (&acc)[2][2][4][2], const Unit& u, int wr, int wc, int fr, int fq) const {
        const int row0 = u.pm * BM + wr * 64 + fr, col0 = u.pn * BM + wc * 64 + 16 * fq;
#pragma unroll
        for (int ai = 0; ai < 2; ++ai)
#pragma unroll
        for (int mh = 0; mh < 2; ++mh) { u32x4 gb[2][2];
#pragma unroll
            for (int mm = 0; mm < 2; ++mm) { const int row = row0 + ai * HALF + (2 * mh + mm) * 16;
#pragma unroll
                for (int bj = 0; bj < 2; ++bj) gb[mm][bj] = *(const u32x4*)(SG + (size_t)row * 4096 + DM + col0 + bj * 8); }
#pragma unroll
            for (int mm = 0; mm < 2; ++mm) { const int m = 2 * mh + mm; const int row = row0 + ai * HALF + m * 16;
                u32x4 w4;
#pragma unroll
                for (int bj = 0; bj < 2; ++bj) { constexpr float DS = MIX8_SCALE / (W8_SCALE * O8_SCALE); const u32x4 g = gb[mm][bj]; f32x4 v0 = acc[ai][bj][m][0] * DS, v1 = acc[ai][bj][m][1] * DS;
                    v0[0] *= bflo(g.x); v0[1] *= bfhi(g.x); v0[2] *= bflo(g.y); v0[3] *= bfhi(g.y); v1[0] *= bflo(g.z); v1[1] *= bfhi(g.z); v1[2] *= bflo(g.w); v1[3] *= bfhi(g.w);
                    const unsigned wx = pk4_fp8(sat8(v0[0]), sat8(v0[1]), sat8(v0[2]), sat8(v0[3])), wy = pk4_fp8(sat8(v1[0]), sat8(v1[1]), sat8(v1[2]), sat8(v1[3]));
                    if (bj == 0) { w4.x = wx; w4.y = wy; } else { w4.z = wx; w4.w = wy; } }
                *(u32x4*)(MIX8 + (size_t)row * DM + col0) = w4; } }
    }
};
struct EpiResid {
    static constexpr bool PERM = true, HAS_MID = false;
    const float* X; bf16* X2; unsigned char* HN8; const float* gf;
    __device__ __forceinline__ void operator()(const f32x4 (&acc)[2][2][4][2], const Unit& u, int wr, int wc, int fr, int fq) const {
        const int row0 = u.pm * BM + wr * 64 + fr, col0 = u.pn * BM + wc * 64 + 16 * fq;
        f32x4 gv[2][2];
#pragma unroll
        for (int bj = 0; bj < 2; ++bj)
#pragma unroll
            for (int n = 0; n < 2; ++n) gv[bj][n] = *(const f32x4*)(gf + col0 + bj * 8 + n * 4);
#pragma unroll
        for (int ai = 0; ai < 2; ++ai) {
            f32x4 xv[4][2][2];
#pragma unroll
            for (int m = 0; m < 4; ++m) { const size_t off = (size_t)(row0 + ai * HALF + m * 16) * DM + col0;
#pragma unroll
                for (int bj = 0; bj < 2; ++bj)
#pragma unroll
                    for (int n = 0; n < 2; ++n) xv[m][bj][n] = *(const f32x4*)(X + off + bj * 8 + n * 4); }
#pragma unroll
            for (int m = 0; m < 4; ++m) { const size_t off = (size_t)(row0 + ai * HALF + m * 16) * DM + col0;
                u32x4 hw4;
#pragma unroll
                for (int bj = 0; bj < 2; ++bj) { constexpr float DS = 1.0f / (W8_SCALE * MIX8_SCALE); const f32x4 v0 = xv[m][bj][0] + acc[ai][bj][m][0] * DS, v1 = xv[m][bj][1] + acc[ai][bj][m][1] * DS;
                    u32x4 w; w.x = cvt_pk_bf16(v0[0], v0[1]); w.y = cvt_pk_bf16(v0[2], v0[3]); w.z = cvt_pk_bf16(v1[0], v1[1]); w.w = cvt_pk_bf16(v1[2], v1[3]);
                    *(u32x4*)(X2 + off + bj * 8) = w;
                    const f32x4 h0 = v0 * gv[bj][0], h1 = v1 * gv[bj][1]; const unsigned hx = pk4_fp8(h0[0], h0[1], h0[2], h0[3]), hy = pk4_fp8(h1[0], h1[1], h1[2], h1[3]);
                    if (bj == 0) { hw4.x = hx; hw4.y = hy; } else { hw4.z = hx; hw4.w = hy; } }
                *(u32x4*)(HN8 + off) = hw4; } }
    }
};
struct EpiSwiglu {
    static constexpr bool PERM = true, HAS_MID = false;
    unsigned char* ACT; const float* b1; const float* rowrstd;
    __device__ __forceinline__ void operator()(const f32x4 (&acc)[2][2][4][2], const Unit& u, int wr, int wc, int fr, int fq) const {
        const int row0 = u.pm * BM + wr * 64 + fr, j0 = u.pn * 128 + wc * 32 + 8 * fq;
        const float* rrs = rowrstd + (u.rb - u.pm * BM);
        const float* bp = b1 + (size_t)u.e * 4096 + 2 * j0;
        const f32x4 q0 = *(const f32x4*)(bp), q1 = *(const f32x4*)(bp + 4), q2 = *(const f32x4*)(bp + 8), q3 = *(const f32x4*)(bp + 12);
        const f32x4 bg0 = {q0[0], q0[2], q1[0], q1[2]}, bl0 = {q0[1], q0[3], q1[1], q1[3]}, bg1 = {q2[0], q2[2], q3[0], q3[2]}, bl1 = {q2[1], q2[3], q3[1], q3[3]};
#pragma unroll
        for (int ai = 0; ai < 2; ++ai) { float rs[4];
#pragma unroll
            for (int m = 0; m < 4; ++m) rs[m] = rrs[row0 + ai * HALF + m * 16] * (1.0f / W8_SCALE);
#pragma unroll
            for (int m = 0; m < 4; ++m) { const int row = row0 + ai * HALF + m * 16; const float DS = rs[m];
                const f32x4 g0 = acc[ai][0][m][0] * DS + bg0, g1 = acc[ai][0][m][1] * DS + bg1, l0 = acc[ai][1][m][0] * DS + bl0, l1 = acc[ai][1][m][1] * DS + bl1;
                f32x2 o2[4];
#pragma unroll
                for (int p = 0; p < 4; ++p) { const f32x4& gs = (p < 2) ? g0 : g1; const f32x4& ls = (p < 2) ? l0 : l1; const int i0 = 2 * (p & 1);
                    const f32x2 ga = {fminf(gs[i0], SW_LIMIT), fminf(gs[i0 + 1], SW_LIMIT)};
                    const f32x2 la = {__builtin_amdgcn_fmed3f(ls[i0], -SW_LIMIT, SW_LIMIT), __builtin_amdgcn_fmed3f(ls[i0 + 1], -SW_LIMIT, SW_LIMIT)};
                    const f32x2 ex = ga * (-SW_ALPHA * 1.4426950408889634f);
                    const f32x2 dn = (f32x2){__builtin_amdgcn_exp2f(ex[0]), __builtin_amdgcn_exp2f(ex[1])} + 1.0f;
                    const f32x2 rc = {__builtin_amdgcn_rcpf(dn[0]), __builtin_amdgcn_rcpf(dn[1])};
                    o2[p] = (ga * rc) * (la * ACT8_SCALE + ACT8_SCALE); }
                u32x2 w; w.x = pk4_fp8(o2[0][0], o2[0][1], o2[1][0], o2[1][1]); w.y = pk4_fp8(o2[2][0], o2[2][1], o2[3][0], o2[3][1]);
                *(u32x2*)(ACT + (size_t)row * DFF + j0) = w; } }
    }
};
struct EpiDown {
    static constexpr bool PERM = true, HAS_MID = false;
    unsigned char* Y; const float* b2; const float* roww;
    __device__ __forceinline__ void operator()(const f32x4 (&acc)[2][2][4][2], const Unit& u, int wr, int wc, int fr, int fq) const {
        const int row0 = u.pm * BM + wr * 64 + fr, col0 = u.pn * BM + wc * 64 + 16 * fq;
        const float* rww = roww + (u.rb - u.pm * BM);
        const float* bp = b2 + (size_t)u.e * DM + col0;
        f32x4 bv[2][2];
#pragma unroll
        for (int bj = 0; bj < 2; ++bj)
#pragma unroll
            for (int n = 0; n < 2; ++n) bv[bj][n] = *(const f32x4*)(bp + bj * 8 + 4 * n);
        float wg[2][4];
#pragma unroll
        for (int ai = 0; ai < 2; ++ai)
#pragma unroll
            for (int m = 0; m < 4; ++m) wg[ai][m] = rww[row0 + ai * HALF + m * 16] * Y8_SCALE;
#pragma unroll
        for (int ai = 0; ai < 2; ++ai)
#pragma unroll
            for (int m = 0; m < 4; ++m) { const int row = row0 + ai * HALF + m * 16; const float wgt = wg[ai][m]; unsigned char* rowp = Y + (size_t)row * DM + col0;
                u32x4 w4;
#pragma unroll
                for (int bj = 0; bj < 2; ++bj) { constexpr float DS = 1.0f / (W8_SCALE * ACT8_SCALE); const f32x4 v0 = (acc[ai][bj][m][0] * DS + bv[bj][0]) * wgt, v1 = (acc[ai][bj][m][1] * DS + bv[bj][1]) * wgt;
                    const unsigned wx = pk4_fp8(sat8(v0[0]), sat8(v0[1]), sat8(v0[2]), sat8(v0[3])), wy = pk4_fp8(sat8(v1[0]), sat8(v1[1]), sat8(v1[2]), sat8(v1[3]));
                    if (bj == 0) { w4.x = wx; w4.y = wy; } else { w4.z = wx; w4.w = wy; } }
                *(u32x4*)rowp = w4; }
    }
};
}

namespace att {
constexpr int D = 128, PQ = BW, PO = DM;
constexpr float SCALE = 0.08838834764831845f;
constexpr int NW = 8, QBLK = 32, KVBLK = 64, QB = NW * QBLK;
constexpr int SHM_V = KVBLK * D * 2, SHM_K = KVBLK * D * 2;
constexpr int BIAS_OFF = 2 * SHM_V + 2 * SHM_K + NW * 64 * 4;
constexpr int LDS_BYTES = BIAS_OFF + 2 * SEQ * 4;
constexpr float THR = 8.f;
constexpr unsigned WBIG = 1u << 30;
static_assert(LDS_BYTES <= RING_BYTES, "attention scratch inside the ring region");
#define KSWZ(row, colB) ((row) * 256 + ((colB) ^ (((row) & 7) << 4)))
#define SBAR() __builtin_amdgcn_sched_barrier(0)
__device__ __forceinline__ int v_st(int k, int c) { const int kk = (k & ~0xC) | ((k & 4) << 1) | ((k & 8) >> 1); return ((kk >> 3) * 4 + (c >> 5)) * 512 + ((kk & 7) * 32 + (c & 31)) * 2; }
__device__ __forceinline__ int v_rd_base(int lane) { return ((lane & 3) << 3) | (((lane >> 2) & 3) << 6) | (((lane >> 4) & 1) << 5) | (((lane >> 5) & 1) << 8); }
constexpr int v_rd_off(int d0, int ks, int half) { return d0 * 512 + ks * 4096 + half * 2048; }
__device__ __forceinline__ int crow(int r, int hi) { return (r & 3) + 8 * (r >> 2) + 4 * hi; }
__device__ __forceinline__ unsigned cvtpk(float lo, float hi) { return cvt_pk_bf16(lo, hi); }
__device__ __forceinline__ bf16x8 load8(const bf16* p) { return *reinterpret_cast<const bf16x8*>(p); }
__device__ __forceinline__ void mask_tile(f32x16& p0, f32x16& p1, int dq, unsigned W) {
    const float NEG = -__builtin_inff();
#pragma unroll
    for (int r = 0; r < 16; ++r) {
        const int c = (r & 3) + 8 * (r >> 2);
        if ((unsigned)(dq - c) >= W) p0[r] = NEG;
        if ((unsigned)(dq - c - 32) >= W) p1[r] = NEG;
    }
}
__device__ __forceinline__ void partialSM(f32x16& p0, f32x16& p1, float& m_reg, float& mn, float& alpha) {
    float pmax = p0[0];
#pragma unroll
    for (int r = 1; r < 16; ++r) pmax = fmaxf(pmax, p0[r]);
#pragma unroll
    for (int r = 0; r < 16; ++r) pmax = fmaxf(pmax, p1[r]);
    { auto rr = __builtin_amdgcn_permlane32_swap(__float_as_uint(pmax), __float_as_uint(pmax), false, false);
      pmax = fmaxf(__uint_as_float(rr[0]), __uint_as_float(rr[1])); }
    constexpr float C2 = 1.4426950408889634f * SCALE;
    if (__builtin_expect(__all((pmax - m_reg) * SCALE <= THR), 1)) { mn = m_reg; alpha = 1.f; }
    else { mn = fmaxf(m_reg, pmax); alpha = __builtin_amdgcn_exp2f((m_reg - mn) * C2); m_reg = mn; }
    const float mnL = -mn * C2;
#pragma unroll
    for (int r = 0; r < 16; ++r) p0[r] = fmaf(p0[r], C2, mnL);
#pragma unroll
    for (int r = 0; r < 16; ++r) p1[r] = fmaf(p1[r], C2, mnL);
#pragma unroll
    for (int r = 0; r < 16; ++r) p0[r] = __builtin_amdgcn_exp2f(p0[r]);
}
__device__ __forceinline__ void finishSM(f32x16& p0, f32x16& p1, float alpha, float& l_reg, bf16x8& pa0, bf16x8& pa1, bf16x8& pa2, bf16x8& pa3) {
#pragma unroll
    for (int r = 0; r < 16; ++r) p1[r] = __builtin_amdgcn_exp2f(p1[r]);
    float ps = 0;
#pragma unroll
    for (int r = 0; r < 16; ++r) ps += p0[r];
#pragma unroll
    for (int r = 0; r < 16; ++r) ps += p1[r];
    { auto rr = __builtin_amdgcn_permlane32_swap(__float_as_uint(ps), __float_as_uint(ps), false, false);
      ps = __uint_as_float(rr[0]) + __uint_as_float(rr[1]); }
    l_reg = l_reg * alpha + ps;
#define PK4(P, B_, OUT) do { unsigned a0 = cvtpk(P[B_+0], P[B_+1]), a1 = cvtpk(P[B_+2], P[B_+3]);                          \
        unsigned b0 = cvtpk(P[B_+4], P[B_+5]), b1 = cvtpk(P[B_+6], P[B_+7]);                                             \
        auto r0 = __builtin_amdgcn_permlane32_swap(a0, b0, false, false); auto r1 = __builtin_amdgcn_permlane32_swap(a1, b1, false, false); \
        u32x4 w = {r0[0], r1[0], r0[1], r1[1]}; OUT = *reinterpret_cast<bf16x8*>(&w); } while (0)
    PK4(p0, 0, pa0); PK4(p0, 8, pa1); PK4(p1, 0, pa2); PK4(p1, 8, pa3);
#undef PK4
}
template <int KB>
__device__ __forceinline__ void qkt(f32x16& p0, f32x16& p1, const LAS char* K_lds, const LAS char* bt, int r32, int hi, const bf16x8* qr) {
#pragma unroll
    for (int g = 0; g < 4; ++g) { const f32x4 a = *(const LAS f32x4*)(bt + 32 * g), b = *(const LAS f32x4*)(bt + 128 + 32 * g);
        p0[4 * g + 0] = a[0]; p0[4 * g + 1] = a[1]; p0[4 * g + 2] = a[2]; p0[4 * g + 3] = a[3]; p1[4 * g + 0] = b[0]; p1[4 * g + 1] = b[1]; p1[4 * g + 2] = b[2]; p1[4 * g + 3] = b[3]; }
    const LAS char* kb[4];
#pragma unroll
    for (int dd = 0; dd < 4; ++dd) kb[dd] = K_lds + KB * SHM_K + KSWZ(r32, (dd * 16 + hi * 8) * 2);
#pragma unroll
    for (int d0 = 0; d0 < 8; ++d0) { const LAS char* a = kb[d0 & 3] + (d0 >> 2) * 128;
        bf16x8 b0 = *reinterpret_cast<const LAS bf16x8*>(a);
        bf16x8 b1 = *reinterpret_cast<const LAS bf16x8*>(a + 32 * 256);
        p0 = __builtin_amdgcn_mfma_f32_32x32x16_bf16(b0, qr[d0], p0, 0, 0, 0);
        p1 = __builtin_amdgcn_mfma_f32_32x32x16_bf16(b1, qr[d0], p1, 0, 0, 0); }
}
template <int VB>
__device__ __forceinline__ void pv_tile(f32x16* o, int vb0, bf16x8 pa0, bf16x8 pa1, bf16x8 pa2, bf16x8 pa3) {
#define TRRD(dst, off) asm volatile("ds_read_b64_tr_b16 %0, %1 offset:%2" : "=&v"(dst) : "v"(vb0), "i"(off) : "memory")
#define PV_D0(d0) do { s16x4 l0, l1, l2, l3, h0, h1, h2, h3; constexpr int b_ = VB * SHM_V + v_rd_off(d0, 0, 0); \
        TRRD(l0, b_); TRRD(h0, b_ + 2048); TRRD(l1, b_ + 4096); TRRD(h1, b_ + 6144); TRRD(l2, b_ + 8192); TRRD(h2, b_ + 10240); TRRD(l3, b_ + 12288); TRRD(h3, b_ + 14336); \
        asm volatile("s_waitcnt lgkmcnt(0)" ::: "memory"); SBAR();   \
        o[d0] = __builtin_amdgcn_mfma_f32_32x32x16_bf16(pa0, (bf16x8){l0[0], l0[1], l0[2], l0[3], h0[0], h0[1], h0[2], h0[3]}, o[d0], 0, 0, 0);   \
        o[d0] = __builtin_amdgcn_mfma_f32_32x32x16_bf16(pa1, (bf16x8){l1[0], l1[1], l1[2], l1[3], h1[0], h1[1], h1[2], h1[3]}, o[d0], 0, 0, 0);   \
        o[d0] = __builtin_amdgcn_mfma_f32_32x32x16_bf16(pa2, (bf16x8){l2[0], l2[1], l2[2], l2[3], h2[0], h2[1], h2[2], h2[3]}, o[d0], 0, 0, 0);   \
        o[d0] = __builtin_amdgcn_mfma_f32_32x32x16_bf16(pa3, (bf16x8){l3[0], l3[1], l3[2], l3[3], h3[0], h3[1], h3[2], h3[3]}, o[d0], 0, 0, 0); } while (0)
    PV_D0(0); PV_D0(1); PV_D0(2); PV_D0(3);
#undef PV_D0
#undef TRRD
}
struct BlockRef { const bf16* Q; const bf16* K; const bf16* V; unsigned char* O; const float* bias; const unsigned* sel; int P0; };
struct Seam { bf16x8 qr[8]; bf16x8 st_v0, st_v1, st_k0, st_k1; int par; };
#define VMW() asm volatile("s_waitcnt vmcnt(0)" ::: "memory")
#define VMWN(n) asm volatile("s_waitcnt vmcnt(%0)" :: "i"(n) : "memory")
#define SLOAD_H(Kp, Vp, k0) do { const char* kp_ = (const char*)(Kp) + (size_t)(k0) * (PQ * 2); const char* vp_ = (const char*)(Vp) + (size_t)(k0) * (PQ * 2);   \
                         S.st_v0 = *(const bf16x8*)(vp_ + kvo); S.st_v1 = *(const bf16x8*)(vp_ + 32 * PQ * 2 + kvo);                                 \
                         S.st_k0 = *(const bf16x8*)(kp_ + kvo); S.st_k1 = *(const bf16x8*)(kp_ + 32 * PQ * 2 + kvo); } while (0)
#define QLOAD(Qp) do { const char* qp_ = (const char*)(Qp) + (size_t)(wid * QBLK) * (PQ * 2); _Pragma("unroll") for (int d0 = 0; d0 < 8; ++d0) S.qr[d0] = *(const bf16x8*)(qp_ + d0 * 32 + qo); } while (0)
#define SWRITE_HK(bf) do { *(LAS bf16x8*)(K_lds + (bf) * SHM_K + kws) = S.st_k0; *(LAS bf16x8*)(K_lds + (bf) * SHM_K + kws + 32 * 256) = S.st_k1; } while (0)
#define SWRITE_HV(bf) do { *(LAS bf16x8*)(V_lds + (bf) * SHM_V + vst0) = S.st_v0; *(LAS bf16x8*)(V_lds + (bf) * SHM_V + vst1) = S.st_v1; } while (0)
#define SWRITE_H(bf) do { SWRITE_HV(bf); SWRITE_HK(bf); } while (0)
__device__ __forceinline__ void attn_prime(const BlockRef& cur, LAS char* lds, Seam& S, int wave) {
    const int wid = wave, lane = lane_now(), tid = wid * 64 + lane, r32 = lane & 31, hi = lane >> 5;
    const int sr = tid >> 4, sc = (tid & 15) * 8, kws = KSWZ(sr, sc * 2); LAS char* K_lds = lds + 2 * SHM_V;
    const unsigned kvo = (unsigned)(sr * PQ + sc) * 2u, qo = (unsigned)(r32 * PQ + hi * 8) * 2u;
    QLOAD(cur.Q);
    const f32x4 bz = *(const f32x4*)(cur.bias + tid * 4);
    SLOAD_H(cur.K, cur.V, 0); VMW(); SWRITE_HK(0);
    *(LAS f32x4*)(lds + BIAS_OFF + tid * 16) = bz; S.par = 0;
    __syncthreads();
}
__device__ __forceinline__ void attn_block(const BlockRef& cur, const BlockRef& nxt, LAS char* lds, Seam& S, int wave) {
    const int wid = wave, lane = lane_now(), tid = wid * 64 + lane, r32 = lane & 31, hi = lane >> 5;
    const int NT = (cur.P0 + QB - 1) / KVBLK + 1;
    const int qlo = cur.P0 + wid * QBLK, qm = qlo + r32 - 4 * hi;
    LAS char* V_lds = lds; LAS char* K_lds = lds + 2 * SHM_V;
    LAS float* ws = (LAS float*)(lds + 2 * SHM_V + 2 * SHM_K) + wid * 64; LAS float* li_l = ws; LAS float* al_l = ws + 32;
    const LAS char* bias_l = lds + BIAS_OFF + S.par * (SEQ * 4) + 16 * hi;
    float m_reg = *(const LAS float*)(lds + BIAS_OFF + S.par * (SEQ * 4) + 4 * (qlo + r32)), l_reg = 0; f32x16 o[4] = {};
    const int sr = tid >> 4, sc = (tid & 15) * 8, vst0 = v_st(sr, sc), vst1 = v_st(32 + sr, sc), kws = KSWZ(sr, sc * 2);
    const unsigned kvo = (unsigned)(sr * PQ + sc) * 2u, qo = (unsigned)(r32 * PQ + hi * 8) * 2u, oo = (unsigned)(4 * hi * PO + r32);
    const int vb0 = (int)(unsigned)(size_t)V_lds + v_rd_base(lane);
    const bf16* Kh = cur.K; const bf16* Vh = cur.V;
    unsigned so_ = (unsigned)((wid * QBLK + r32) * 4); asm volatile("" : "+v"(so_));
    const unsigned selw = cur.sel ? *(const unsigned*)((const char*)cur.sel + so_) : 0xffffffffu; const int P0 = cur.P0;
    const f32x4 bz = *(const f32x4*)(nxt.bias + tid * 4);
#define RESC(a) do { if (__any((a) < 1.f)) { if (hi == 0) al_l[r32] = (a); asm volatile("s_waitcnt lgkmcnt(0)" ::: "memory");              \
                     for (int d_ = 0; d_ < 4; ++d_) for (int r = 0; r < 16; ++r) o[d_][r] *= al_l[crow(r, hi)]; } } while (0)
#define KBASE(t) ((t) * KVBLK)
#define MASKT(P0_, P1_, t) do { const int kb_ = KBASE(t); if (kb_ + KVBLK - 1 > qlo) mask_tile(P0_, P1_, qm - kb_, WBIG);                                  \
        if (kb_ < P0) { const bool keep_ = ((selw >> (kb_ >> 8)) & 1u) != 0u; if (!__all(keep_)) { const float NEG_ = -__builtin_inff();                     \
            _Pragma("unroll") for (int r = 0; r < 16; ++r) { P0_[r] = keep_ ? P0_[r] : NEG_; P1_[r] = keep_ ? P1_[r] : NEG_; } } } } while (0)
    constexpr int NQL = 8;
#define SEAM_K0() do { VMWN(NQL); SWRITE_HK(0); SBAR(); } while (0)
    f32x16 pA0, pA1, pB0, pB1; float mnA, mnB, alA, alB; bf16x8 pa0, pa1, pa2, pa3;
    SWRITE_HV(0); SBAR();
    if (NT > 1) { SLOAD_H(Kh, Vh, KBASE(1)); }
    SBAR(); qkt<0>(pA0, pA1, K_lds, bias_l + 4 * KBASE(0), r32, hi, S.qr);
    MASKT(pA0, pA1, 0); partialSM(pA0, pA1, m_reg, mnA, alA);
    if (NT > 1) { VMW(); SWRITE_H(1); }
    *(LAS f32x4*)(lds + BIAS_OFF + (S.par ^ 1) * (SEQ * 4) + tid * 16) = bz;
    __syncthreads();
#define HALF_STEP(PX0, PX1, mnX, alX, PY0, PY1, alY, t, KB, VB, SB) do {                                                      \
        SBAR(); qkt<KB>(PX0, PX1, K_lds, bias_l + 4 * KBASE(t), r32, hi, S.qr);                                               \
        finishSM(PY0, PY1, alY, l_reg, pa0, pa1, pa2, pa3); SBAR();                                                           \
        if ((t) + 1 < NT) { SLOAD_H(Kh, Vh, KBASE((t) + 1)); SBAR(); }                                                        \
        pv_tile<VB>(o, vb0, pa0, pa1, pa2, pa3); MASKT(PX0, PX1, (t)); partialSM(PX0, PX1, m_reg, mnX, alX);                  \
        __syncthreads();                                                                                                      \
        if ((t) + 1 < NT) { VMW(); SWRITE_H(SB); }                                                                            \
        RESC(alX); __syncthreads(); } while (0)
    for (int t = 1; t + 1 < NT; t += 2) {
        HALF_STEP(pB0, pB1, mnB, alB, pA0, pA1, alA, t, 1, 0, 0);
        HALF_STEP(pA0, pA1, mnA, alA, pB0, pB1, alB, t + 1, 0, 1, 1);
    }
    const bool even = (NT & 1) == 0;
    if (even) { SBAR(); qkt<1>(pB0, pB1, K_lds, bias_l + 4 * KBASE(NT - 1), r32, hi, S.qr); SBAR(); }
    SLOAD_H(nxt.K, nxt.V, 0); SBAR();
    QLOAD(nxt.Q);
    SBAR();
    finishSM(pA0, pA1, alA, l_reg, pa0, pa1, pa2, pa3); SBAR();
    pv_tile<0>(o, vb0, pa0, pa1, pa2, pa3);
    if (even) { MASKT(pB0, pB1, NT - 1); partialSM(pB0, pB1, m_reg, mnB, alB); __syncthreads(); RESC(alB);
        finishSM(pB0, pB1, alB, l_reg, pa0, pa1, pa2, pa3); SBAR(); pv_tile<1>(o, vb0, pa0, pa1, pa2, pa3); }
    SBAR(); SEAM_K0();
    if (hi == 0) li_l[r32] = l_reg; asm volatile("s_waitcnt lgkmcnt(0)" ::: "memory");
    float rli[16];
#pragma unroll
    for (int r = 0; r < 16; ++r) rli[r] = __builtin_amdgcn_rcpf(li_l[crow(r, hi)]);
    char* Ow = (char*)cur.O + (size_t)(wid * QBLK) * PO;
#pragma unroll
    for (int r = 0; r < 16; ++r) { char* Or = Ow + (size_t)((r & 3) + 8 * (r >> 2)) * PO;
#pragma unroll
        for (int d0 = 0; d0 < 4; ++d0) { const float v = o[d0][r] * (rli[r] * O8_SCALE);
            const float vn = __shfl_xor(v, 1);
            const unsigned pr = __builtin_amdgcn_cvt_pk_fp8_f32(v, vn, 0u, false) & 0xffffu; const unsigned pn = (unsigned)__shfl_xor((int)pr, 2);
            if ((r32 & 3) == 0) *(unsigned*)(Or + d0 * 32 + oo) = pr | (pn << 16); } }
    S.par ^= 1;
    __syncthreads();
#undef RESC
#undef KBASE
#undef MASKT
#undef SEAM_K0
#undef HALF_STEP
}
#undef QLOAD
#undef VMW
#undef VMWN
#undef SLOAD_H
#undef SWRITE_HK
#undef SWRITE_HV
#undef SWRITE_H
#undef KSWZ
}

#define XB_TMO      128
#define XB_XCNT(j)  (256  + 64 * (j))
#define XB_XSUB(j)  (1280 + 64 * (j))
#define XB_XGEN(j)  (2304 + 64 * (j))
#define XB_TOP      3328
#define XB_TOPGEN   3392
#define XCD_BAR_WORDS 3456
#define XB_SPIN_CAP (1u << 18)
__device__ __forceinline__ unsigned xb_ld(unsigned* p)              { return __hip_atomic_load(p, __ATOMIC_RELAXED, __HIP_MEMORY_SCOPE_AGENT); }
__device__ __forceinline__ unsigned xb_add(unsigned* p, unsigned v) { return __hip_atomic_fetch_add(p, v, __ATOMIC_RELAXED, __HIP_MEMORY_SCOPE_AGENT); }
__device__ __forceinline__ unsigned xb_xcc_id() { return (unsigned)__builtin_amdgcn_s_getreg((3 << 11) | 20) & 0xFu; }
#define XB_SPIN(cond, bar) do { unsigned _sp = 0; while (cond) { __builtin_amdgcn_s_sleep(1); \
    if ((++_sp & 255u) == 0u) { if (xb_ld(&(bar)[XB_TMO])) break; if (_sp > XB_SPIN_CAP) { atomicAdd(&(bar)[XB_TMO], 1u); break; } } } } while (0)
struct XcdBarrier { unsigned* bar; unsigned x; volatile LAS unsigned* st; int wave; };
__device__ __forceinline__ XcdBarrier xcd_barrier_post(unsigned* bar, volatile LAS unsigned* st, int wave) {
    XcdBarrier b; b.bar = bar; b.x = xb_xcc_id(); b.st = st; b.wave = wave;
    if (wave == 0 && lane_now() == 0) (void)xb_add(&bar[XB_XCNT(b.x)], 1u);
    return b;
}
__device__ __forceinline__ void xcd_barrier_complete(unsigned* bar, unsigned x, unsigned& nloc, unsigned& nx) {
    const unsigned G = gridDim.x * gridDim.y * gridDim.z;
    unsigned sum, cnt, mine, sp = 0u;
    for (;;) {
        sum = 0u; cnt = 0u; mine = 0u;
#pragma unroll
        for (unsigned j = 0; j < 16; ++j) { const unsigned c = xb_ld(&bar[XB_XCNT(j)]); sum += c; cnt += (c > 0u) ? 1u : 0u; mine = (j == x) ? c : mine; }
        if (sum == G) break;
        __builtin_amdgcn_s_sleep(1);
        if ((++sp & 255u) == 0u) { if (xb_ld(&bar[XB_TMO])) break; if (sp > XB_SPIN_CAP) { atomicAdd(&bar[XB_TMO], 1u); break; } }
    }
    nloc = mine > 0u ? mine : 1u; nx = cnt > 0u ? cnt : 1u;
}
__device__ __forceinline__ void xcd_barrier(const XcdBarrier& b) {
    asm volatile("s_waitcnt vmcnt(0)" ::: "memory");
    __syncthreads();
    if (b.wave == 0 && lane_now() == 0) {
        unsigned* bar = b.bar;
        __builtin_amdgcn_s_waitcnt(0);
        unsigned nloc = b.st[0], nx = b.st[1];
        if (nloc == 0u) { xcd_barrier_complete(bar, b.x, nloc, nx); b.st[0] = nloc; b.st[1] = nx; }
        const unsigned old = xb_add(&bar[XB_XSUB(b.x)], 1u);
        const unsigned gen = old / nloc;
        if (old + 1u == (gen + 1u) * nloc) {
            __builtin_amdgcn_fence(__ATOMIC_RELEASE, "agent");
            asm volatile("s_waitcnt vmcnt(0)" ::: "memory");
            const unsigned og = xb_add(&bar[XB_TOP], 1u);
            const unsigned tg = og / nx;
            if (og + 1u == (tg + 1u) * nx) xb_add(&bar[XB_TOPGEN], 1u);
            else XB_SPIN(xb_ld(&bar[XB_TOPGEN]) == tg, bar);
            __builtin_amdgcn_fence(__ATOMIC_ACQUIRE, "agent");
            xb_add(&bar[XB_XGEN(b.x)], 1u);
            asm volatile("s_waitcnt vmcnt(0)" ::: "memory");
        } else {
            XB_SPIN(xb_ld(&bar[XB_XGEN(b.x)]) == gen, bar);
            __builtin_amdgcn_fence(__ATOMIC_ACQUIRE, "agent");
            asm volatile("s_waitcnt vmcnt(0)" ::: "memory");
        }
    }
    __syncthreads();
}

struct Args { const float* in[15]; float* out; unsigned char* ws; int ph_lo, ph_hi; };
struct Frame {
    LAS unsigned char* lds; volatile LAS unsigned* MISC; unsigned* ctl;
    int tid, lane, wave, vcu, G, gw, NGW;
    unsigned char* ws;
};
__device__ const float kInvFreq[16] = {1.0f, 0.44036662578582764f, 0.193922758102417f, 0.08539710193872452f, 0.03760603070259094f, 0.016560440883040428f, 0.00729266507551074f, 0.0032114461064338684f,
    0.001414213445968926f, 0.0006227724370546639f, 0.00027424818836152554f, 0.00012076974235242233f, 5.318296462064609e-05f, 2.3419997887685895e-05f, 1.0313385246263351e-05f, 4.541670477919979e-06f};

template <int MAP  >
__device__ __forceinline__ void p0_strip(const float* W, int ldw, int k0, int nsrc0, unsigned char* WT, int K, int nv0, float scale, int lane, LAS unsigned char* wl) {
    asm volatile("" : "+v"(lane));
    const int rg = lane >> 4, cg = lane & 15;
    const unsigned so = (unsigned)((k0 + 16 * rg) * ldw + nsrc0 + 4 * cg) * 4u, sld = (unsigned)ldw * 4u;
    f32x4 va[16], vb[16];
#define P0_LOAD(v, kk) do { _Pragma("unroll") for (int j = 0; j < 16; ++j) v[j] = __builtin_nontemporal_load((const f32x4*)((const char*)W + (so + (unsigned)((kk) + j) * sld))); } while (0)
#define P0_CONV(v, kk) do { _Pragma("unroll") for (int i = 0; i < 4; ++i) { u32x4 o; \
            o.x = pk4_fp8(v[0][i] * scale, v[1][i] * scale, v[2][i] * scale, v[3][i] * scale); o.y = pk4_fp8(v[4][i] * scale, v[5][i] * scale, v[6][i] * scale, v[7][i] * scale); \
            o.z = pk4_fp8(v[8][i] * scale, v[9][i] * scale, v[10][i] * scale, v[11][i] * scale); o.w = pk4_fp8(v[12][i] * scale, v[13][i] * scale, v[14][i] * scale, v[15][i] * scale); \
            *(LAS u32x4*)(wl + (4 * cg + i) * 144 + ((kk) & 64) + 16 * rg) = o; } } while (0)
#define P0_FLUSH(kh) do { _Pragma("unroll") for (int s_ = 0; s_ < 8; ++s_) { const int r_ = (lane >> 3) + 8 * s_, nv_ = nv0 + r_; int row_ = nv_; if (MAP == 1) { const int jj_ = nv_ >> 1; row_ = ((jj_ >> 7) << 8) + ((jj_ & 120) << 1) + ((nv_ & 1) << 3) + (jj_ & 7); } \
            const u32x4 o_ = *(const LAS u32x4*)(wl + r_ * 144 + (lane & 7) * 16); __builtin_nontemporal_store(o_, (GAS u32x4*)(WT + (size_t)row_ * K + k0 + (kh) + (lane & 7) * 16)); } } while (0)
    P0_LOAD(va, 0);
    P0_LOAD(vb, 64);  P0_CONV(va, 0);   asm volatile("" ::: "memory");
    P0_LOAD(va, 128); P0_CONV(vb, 64);  P0_FLUSH(0); asm volatile("" ::: "memory");
    P0_LOAD(vb, 192); P0_CONV(va, 128); asm volatile("" ::: "memory");
    P0_CONV(vb, 192); P0_FLUSH(128);
#undef P0_LOAD
#undef P0_CONV
#undef P0_FLUSH
}
__device__ __forceinline__ void sincos_d(double a, float& c, float& s) {
    const double k = __builtin_rint(a * 0.63661977236758134308);
    double r = __builtin_fma(-k, 1.57079632679489655800e+00, a); r = __builtin_fma(-k, 6.12323399573676603587e-17, r);
    const double r2 = r * r;
    double sp = -1.0 / 1307674368000.0; sp = sp * r2 + 1.0 / 6227020800.0; sp = sp * r2 - 1.0 / 39916800.0; sp = sp * r2 + 1.0 / 362880.0; sp = sp * r2 - 1.0 / 5040.0; sp = sp * r2 + 1.0 / 120.0; sp = sp * r2 - 1.0 / 6.0; sp = sp * r2 * r + r;
    double cp = 1.0 / 20922789888000.0; cp = cp * r2 - 1.0 / 87178291200.0; cp = cp * r2 + 1.0 / 479001600.0; cp = cp * r2 - 1.0 / 3628800.0; cp = cp * r2 + 1.0 / 40320.0; cp = cp * r2 - 1.0 / 720.0; cp = cp * r2 + 1.0 / 24.0; cp = cp * r2 - 0.5; cp = cp * r2 + 1.0;
    const int q = ((int)k) & 3;
    const double cc = (q == 0) ? cp : (q == 1) ? -sp : (q == 2) ? -cp : sp;
    const double ss = (q == 0) ? sp : (q == 1) ? cp : (q == 2) ? -sp : -cp;
    c = (float)cc; s = (float)ss;
}

__global__ void __launch_bounds__(NWAVES * 64, 2) fwd_kernel(Args args) {
    extern __shared__ __attribute__((aligned(16))) unsigned char lds[];
    Frame F;
    F.lds = (LAS unsigned char*)lds; F.MISC = (volatile LAS unsigned*)(F.lds + MISC_OFF);
    F.tid = threadIdx.x; F.lane = F.tid & 63; F.wave = __builtin_amdgcn_readfirstlane(F.tid >> 6);
    F.G = gridDim.x; { const int bx = blockIdx.x; F.vcu = (F.G % 8 == 0) ? (bx % 8) * (F.G / 8) + bx / 8 : bx; }
    F.gw = F.vcu * NWAVES + F.wave; F.NGW = F.G * NWAVES;
    F.ws = args.ws; F.ctl = (unsigned*)(args.ws + WS_CTL);
    unsigned char* const ws = args.ws;
    for (int u = F.tid; u < (LDS_BYTES - LDSCTL_OFF) / 4; u += NWAVES * 64) ((LAS unsigned*)(F.lds + LDSCTL_OFF))[u] = 0u;
    __syncthreads();
    XcdBarrier bar; bar.bar = F.ctl + CW_BAR; bar.x = 0; bar.st = nullptr; bar.wave = 0;
    if (!MK_PER_PHASE) bar = xcd_barrier_post(F.ctl + CW_BAR, F.MISC + 8, F.wave);
#define GRID_BAR() do { if (!MK_PER_PHASE) xcd_barrier(bar); } while (0)
    const int lo = args.ph_lo, hi = args.ph_hi;
#define IN(k) (lo <= (k) && (k) < hi)
#define BOTH(k) (IN(k) && IN((k) + 1))
    const float* x = args.in[0]; const float* g_mix = args.in[1]; const float* w_in = args.in[2]; const float* b_forget = args.in[3];
    const float* w_fox = args.in[4]; const float* w_moba = args.in[5]; const float* w_out = args.in[6]; const float* g_ffn = args.in[7];
    const float* w_router = args.in[8]; const float* b_router = args.in[9]; const float* w_mlp1 = args.in[10]; const float* b_mlp1 = args.in[11];
    const float* w_mlp2 = args.in[12]; const float* b_mlp2 = args.in[13]; const float* g_final = args.in[14];
    unsigned char* Wt_in = ws + WS_WIN; unsigned char* Wt_cat = ws + WS_WFOX; unsigned char* Wt_out = ws + WS_WOUT;
    unsigned char* Wt_1 = ws + WS_W1; unsigned char* Wt_2 = ws + WS_W2; float* WR = (float*)(ws + WS_WR);
    float* RCOS = (float*)(ws + WS_ROPE); float* RSIN = RCOS + SEQ * 16;
    float* LOGF = (float*)(ws + WS_LOGF); float* BIAS = (float*)(ws + WS_BIAS); float* KMEAN = (float*)(ws + WS_KMEAN); unsigned* SELB = (unsigned*)(ws + WS_SELB);
    int* EIDX = (int*)(ws + WS_EIDX); float* EW = (float*)(ws + WS_EW); int* RANK = (int*)(ws + WS_RANK); int* POS = (int*)(ws + WS_POS); float* RSTD = (float*)(ws + WS_RSTD); float* ROWW = (float*)(ws + WS_ROWW);
    unsigned char* Hb = ws + WS_H; bf16* QKV = (bf16*)(ws + WS_QKV); bf16* SG = (bf16*)(ws + WS_SG); unsigned char* Ob = ws + WS_O; unsigned char* MIX8 = ws + WS_H;
    bf16* X2 = (bf16*)(ws + WS_X2); unsigned char* HN8 = ws + WS_AS; int* ROWTOK = (int*)(ws + WS_AS + 80 * MiB); float* ROWRSTD = (float*)(ws + WS_AS + 96 * MiB); float* ROWWE = (float*)(ws + WS_AS + 88 * MiB);     unsigned char* ACT = ws + WS_ACT;
    unsigned char* Yb = ws + WS_Y;

    if (IN(0)) {
    _Pragma("unroll") for (int rep_ = 0; rep_ <= REP(0); ++rep_) {
        constexpr int I_IN = (NV_IN / 64) * 8, I_BR = 32 * 4, I_OUT = 32 * 8, I_W1 = 64 * 8, I_W2 = 32 * 8;
        constexpr int NITEMS = I_IN + 2 * I_BR + I_OUT;
        LAS unsigned char* wl = F.lds + F.wave * 9216;
        _Pragma("unroll") for (int rp_ = 0; rp_ <= REP(12); ++rp_)
        for (int it = F.gw; it < NITEMS; it += F.NGW) {
            int r = it;
            if (r < I_IN) { const int nb = r >> 3, kb = r & 7, nv0 = 64 * nb; p0_strip<0>(w_in, IN_COLS, 256 * kb, nv0 + (nv0 >= FL_COL ? 8 : 0), Wt_in, DM, nv0, W8_SCALE, F.lane, wl); continue; } r -= I_IN;
            if (r < I_BR) { const int nb = r >> 2, kb = r & 3; p0_strip<0>(w_fox, DM, 256 * kb, 64 * nb, Wt_cat, DM, 64 * nb, W8_SCALE, F.lane, wl); continue; } r -= I_BR;
            if (r < I_BR) { const int nb = r >> 2, kb = r & 3; p0_strip<0>(w_moba, DM, 256 * kb, 64 * nb, Wt_cat + BW, DM, 64 * nb, W8_SCALE, F.lane, wl); continue; } r -= I_BR;
            { const int nb = r >> 3, kb = r & 7; p0_strip<0>(w_out, DM, 256 * kb, 64 * nb, Wt_out, DM, 64 * nb, W8_SCALE, F.lane, wl); }
        }
        for (int i = F.gw * 64 + F.lane; i < SEQ * 16; i += F.NGW * 64) { const int pos = i >> 4, j = i & 15; const float ang = (float)pos * kInvFreq[j]; float c, s; sincos_d((double)ang, c, s); RCOS[i] = c; RSIN[i] = s; }
        for (int i = F.gw * 64 + F.lane; i < 64 * 1024; i += F.NGW * 64) { const int c = i >> 10, ln = (i >> 4) & 63, eh = (i >> 3) & 1, s = i & 7, k = 32 * c + 8 * (ln >> 4) + s, e = (ln & 15) + 16 * eh; WR[i] = g_ffn[k] * w_router[k * NE + e]; }
        __syncthreads();
        LAS float* wf = (LAS float*)F.lds;
        for (int k = F.tid; k < DM; k += NWAVES * 64) { const float g = g_mix[k]; const f32x4 a = *(const f32x4*)(w_in + (size_t)k * IN_COLS + FL_COL), b = *(const f32x4*)(w_in + (size_t)k * IN_COLS + FL_COL + 4);
            wf[0 * DM + k] = a[0] * g; wf[1 * DM + k] = a[1] * g; wf[2 * DM + k] = a[2] * g; wf[3 * DM + k] = a[3] * g; wf[4 * DM + k] = b[0] * g; wf[5 * DM + k] = b[1] * g; wf[6 * DM + k] = b[2] * g; wf[7 * DM + k] = b[3] * g; }
        __syncthreads();
        { f32x4 vn[8];
          { const f32x4* xr0 = (const f32x4*)(x + (size_t)F.gw * DM) + F.lane;
#pragma unroll
            for (int j = 0; j < 8; ++j) vn[j] = xr0[64 * j]; }
          for (int m = F.gw; m < T; m += F.NGW) {
            f32x4 v[8]; float ss = 0.f;
#pragma unroll
            for (int j = 0; j < 8; ++j) { v[j] = vn[j]; ss += (v[j][0] * v[j][0] + v[j][1] * v[j][1]) + (v[j][2] * v[j][2] + v[j][3] * v[j][3]); }
            if (m + F.NGW < T) { const f32x4* xr1 = (const f32x4*)(x + (size_t)(m + F.NGW) * DM) + F.lane;
#pragma unroll
                for (int j = 0; j < 8; ++j) vn[j] = xr1[64 * j]; }
            float fl[8];
#pragma unroll
            for (int jj = 0; jj < 8; ++jj) fl[jj] = 0.f;
#pragma unroll
            for (int j = 0; j < 8; ++j) {
#pragma unroll
                for (int jj = 0; jj < 8; ++jj) { const f32x4 w = *(const LAS f32x4*)(wf + jj * DM + 4 * F.lane + 256 * j); fl[jj] += (v[j][0] * w[0] + v[j][1] * w[1]) + (v[j][2] * w[2] + v[j][3] * w[3]); }
                asm volatile("" ::: "memory"); }
#pragma unroll
            for (int o = 1; o < 64; o <<= 1) { ss += __shfl_xor(ss, o);
#pragma unroll
                for (int jj = 0; jj < 8; ++jj) fl[jj] += __shfl_xor(fl[jj], o); }
            const float rstd = 1.0f / sqrtf(ss * (1.0f / DM) + RMS_EPS);
            unsigned* o4 = (unsigned*)(Hb + (size_t)m * DM) + F.lane;
#pragma unroll
            for (int j = 0; j < 8; ++j) { const f32x4 g = *((const f32x4*)g_mix + F.lane + 64 * j); o4[64 * j] = pk4_fp8(v[j][0] * rstd * g[0], v[j][1] * rstd * g[1], v[j][2] * rstd * g[2], v[j][3] * rstd * g[3]); }
            if (F.lane < 8) { float z = 0.f;
#pragma unroll
                for (int jj = 0; jj < 8; ++jj) z = (F.lane == jj) ? fl[jj] : z;
                z = z * rstd + b_forget[F.lane]; LOGF[(size_t)m * 8 + F.lane] = fminf(z, 0.f) - log1pf(expf(-fabsf(z))); }
          } }
    if (REP(0) && rep_ == 0) { VM_WAIT(); __syncthreads(); } }
        if (BOTH(0)) GRID_BAR();
    }

    if (IN(1)) {
    _Pragma("unroll") for (int rep_ = 0; rep_ <= REP(1); ++rep_) {
        pg8::Gemm g{DM, DM, DM}; pg8::DenseOrder S; S.init(Hb, Wt_in, DM, DM, T, NV_IN, F.G, (int)blockIdx.x, 1); S.rep = 1 + REP(14);
        pg8::EpiInProj E{QKV, SG};
        pg8::gemm_phase<pg8::EpiInProj, pg8::DenseOrder, true, false, true>(F.lds, g, S, E, F.wave);
    if (REP(1) && rep_ == 0) { VM_WAIT(); __syncthreads(); } }
        if (BOTH(1)) GRID_BAR();
    }

    const int cls = (int)blockIdx.x & 7, rin = (int)blockIdx.x >> 3;
    const int ngrp = F.G >> 6, nconv = ngrp ? ngrp * 8 * CONV_PER8 : F.G;
    const int r8 = rin & 7, cslot = (r8 * CONV_PER8) >> 3;
    const bool conv8 = r8 == ((cslot * 8 + CONV_PER8 - 1) / CONV_PER8);
    const bool is_conv = ngrp == 0 || ((int)blockIdx.x < ngrp * 64 && conv8);
    const bool ov24 = IN(2) && IN(4) && ngrp != 0 && (F.G & 63) == 0 && !MK_PER_PHASE;
    int gw2 = F.gw, ngw2 = F.NGW;
    if (ov24 && !is_conv) { const int below = (r8 * CONV_PER8 + 7) >> 3;
        gw2 = ((((rin >> 3) * (8 - CONV_PER8) + (r8 - below)) * 8 + cls) * NWAVES) + F.wave; ngw2 = (F.G - nconv) * NWAVES; }
    if (IN(2) && !(ov24 && is_conv)) {
        const int lane2 = (int)__builtin_amdgcn_mbcnt_hi(~0u, __builtin_amdgcn_mbcnt_lo(~0u, 0u));
        for (int it = gw2; it < NB * NH; it += ngw2) { const int b = it >> 3, h = it & 7; const float* lf = LOGF + (size_t)b * SEQ * 8 + h; float v[32]; double tot = 0.0;
#pragma unroll
            for (int i = 0; i < 32; ++i) { v[i] = lf[(size_t)(32 * lane2 + i) * 8]; tot += (double)v[i]; }
            double inc = tot;
#pragma unroll
            for (int o = 1; o < 64; o <<= 1) { const double t = __shfl_up(inc, o); if (lane2 >= o) inc += t; }
            double run = inc - tot; float* bo = BIAS + (size_t)it * SEQ + 32 * lane2;
#pragma unroll
            for (int i = 0; i < 32; ++i) { run += (double)v[i]; bo[i] = (float)(-run * 11.313708498984761); } }
        bf16* Qm = QKV + 3 * QKV_STRIDE; bf16* Km = QKV + 4 * QKV_STRIDE;
        for (int m0 = gw2; m0 < T; m0 += 4 * ngw2) {
            const int i2 = 2 * (lane2 & 7); unsigned w1[4], w2[4]; f32x2 cs[4], sn[4];
#pragma unroll
            for (int r = 0; r < 4; ++r) { const int mr = m0 + r * ngw2, m = mr < T ? mr : m0, pos = m & (SEQ - 1); const bf16* qp = Qm + (size_t)m * BW + (lane2 >> 3) * HD + i2;
                w1[r] = *(const unsigned*)qp; w2[r] = *(const unsigned*)(qp + 16); cs[r] = *(const f32x2*)(RCOS + pos * 16 + i2); sn[r] = *(const f32x2*)(RSIN + pos * 16 + i2); }
#pragma unroll
            for (int r = 0; r < 4; ++r) { const int m = m0 + r * ngw2; if (m >= T) continue; bf16* qp = Qm + (size_t)m * BW + (lane2 >> 3) * HD + i2;
                const float a0 = bflo(w1[r]), a1 = bfhi(w1[r]), b0 = bflo(w2[r]), b1 = bfhi(w2[r]);
                *(unsigned*)qp = pk2(a0 * cs[r][0] - b0 * sn[r][0], a1 * cs[r][1] - b1 * sn[r][1]); *(unsigned*)(qp + 16) = pk2(b0 * cs[r][0] + a0 * sn[r][0], b1 * cs[r][1] + a1 * sn[r][1]); } }
        for (int it = ngw2 - 1 - gw2; it < NB * NH * 8; it += ngw2) { const int blk = it & 7, h = (it >> 3) & 7, b = it >> 6; const int rg = lane2 >> 4, c = lane2 & 15;
            bf16* kp = Km + ((size_t)b * SEQ + blk * 256 + rg) * BW + h * HD + 8 * c; float sm[8];
#pragma unroll
            for (int j = 0; j < 8; ++j) sm[j] = 0.f;
            const bool isrot = c < 4; const float sg = (c < 2) ? -1.f : 1.f; const int jr = 8 * (c & 1);
#pragma unroll 1
            for (int i0 = 0; i0 < 64; i0 += 16) { u32x4 kw[16];
#pragma unroll
                for (int u = 0; u < 16; ++u) kw[u] = *(const u32x4*)(kp + (size_t)(4 * (i0 + u)) * BW);
#pragma unroll
                for (int u = 0; u < 16; ++u) { float a[8] = {bflo(kw[u].x), bfhi(kw[u].x), bflo(kw[u].y), bfhi(kw[u].y), bflo(kw[u].z), bfhi(kw[u].z), bflo(kw[u].w), bfhi(kw[u].w)}; float pr[8];
#pragma unroll
                    for (int j = 0; j < 8; ++j) pr[j] = __shfl_xor(a[j], 2);
                    if (isrot) { const int pos = blk * 256 + 4 * (i0 + u) + rg; const f32x4 c0 = *(const f32x4*)(RCOS + pos * 16 + jr), c1 = *(const f32x4*)(RCOS + pos * 16 + jr + 4), s0 = *(const f32x4*)(RSIN + pos * 16 + jr), s1 = *(const f32x4*)(RSIN + pos * 16 + jr + 4);
#pragma unroll
                        for (int j = 0; j < 4; ++j) { a[j] = a[j] * c0[j] + sg * pr[j] * s0[j]; a[4 + j] = a[4 + j] * c1[j] + sg * pr[4 + j] * s1[j]; }
                        u32x4 o; o.x = pk2(a[0], a[1]); o.y = pk2(a[2], a[3]); o.z = pk2(a[4], a[5]); o.w = pk2(a[6], a[7]); *(u32x4*)(kp + (size_t)(4 * (i0 + u)) * BW) = o; }
#pragma unroll
                    for (int j = 0; j < 8; ++j) sm[j] += a[j]; } }
#pragma unroll
            for (int j = 0; j < 8; ++j) { sm[j] += __shfl_xor(sm[j], 16); sm[j] += __shfl_xor(sm[j], 32); }
            if (rg == 0) { float* ko = KMEAN + (size_t)it * HD + 8 * c; *(f32x4*)ko = (f32x4){sm[0], sm[1], sm[2], sm[3]} * (1.0f / 256.0f); *(f32x4*)(ko + 4) = (f32x4){sm[4], sm[5], sm[6], sm[7]} * (1.0f / 256.0f); } }
        if (ov24) {
            asm volatile("s_waitcnt vmcnt(0)" ::: "memory"); __syncthreads();
            if (F.wave == 0 && lane_now() == 0) { __builtin_amdgcn_fence(__ATOMIC_RELEASE, "agent"); asm volatile("s_waitcnt vmcnt(0)" ::: "memory"); (void)xb_add(F.ctl + CW_P2DONE, 1u); }
        }
    }
    if (IN(2) && !ov24 && BOTH(2)) GRID_BAR();


    if (IN(4)) {
    {
        LAS char* alds = (LAS char*)F.lds;
        const float* zero_bias = (const float*)(F.ctl + CW_ZERO);
        if (is_conv) {
            constexpr int I_W1 = 64 * 8, I_W2 = 32 * 8, NIT = NE * I_W1 + NE * I_W2;
            LAS unsigned char* wl = F.lds + F.wave * 9216; const int lnc = lane_now();
            const int cgw = (ngrp ? ((rin >> 3) * CONV_PER8 + cslot) * 8 + cls : (int)blockIdx.x) * NWAVES + F.wave;
            for (int it = cgw; it < NIT; it += nconv * NWAVES) {
                int r = it;
                if (r < NE * I_W1) { const int e = r / I_W1, q = r % I_W1, kb = q >> 6, nb = q & 63; p0_strip<1>(w_mlp1 + (size_t)e * DM * 4096, 4096, 256 * kb, 64 * nb, Wt_1 + (size_t)e * 4096 * DM, DM, 64 * nb, W8_SCALE, lnc, wl); continue; } r -= NE * I_W1;
                { const int e = r / I_W2, q = r % I_W2, kb = q >> 5, nb = q & 31; p0_strip<0>(w_mlp2 + (size_t)e * DFF * DM, DM, 256 * kb, 64 * nb, Wt_2 + (size_t)e * DM * DFF, DFF, 64 * nb, W8_SCALE, lnc, wl); }
            }
            __syncthreads();
        }
        if (ov24) {
            if (F.wave == 0 && lane_now() == 0) { const unsigned need = (unsigned)(F.G - nconv); XB_SPIN(xb_ld(F.ctl + CW_P2DONE) < need, F.ctl + CW_BAR);
                __builtin_amdgcn_fence(__ATOMIC_ACQUIRE, "agent"); asm volatile("s_waitcnt vmcnt(0)" ::: "memory"); }
            __syncthreads();
        }
        auto mkref = [&](int id) -> att::BlockRef {
            const int q = id >> 8, idx = id & 255, bb = idx >> 3, br = bb >> 4, b = bb & 15, h = q, bh = b * NH + h, qb = 7 - (idx & 7);
            att::BlockRef r; const bf16* base = QKV + (size_t)(br * 3) * QKV_STRIDE;
            r.Q = base + ((size_t)b * SEQ + qb * 256) * BW + h * HD; r.K = base + QKV_STRIDE + (size_t)b * SEQ * BW + h * HD; r.V = base + 2 * QKV_STRIDE + (size_t)b * SEQ * BW + h * HD;
            r.O = Ob + ((size_t)b * SEQ + qb * 256) * DM + br * BW + h * HD;
            r.bias = br ? zero_bias : BIAS + (size_t)bh * SEQ; r.sel = br ? SELB + (size_t)bh * SEQ + qb * 256 : nullptr; r.P0 = qb * 256; return r; };
        auto moba_select = [&](int id) {
            const int q = id >> 8, idx = id & 255, bb = idx >> 3, b = bb & 15, h = q, bh = b * NH + h, own = 7 - (idx & 7);
            int ln = lane_now(); asm volatile("" : "+v"(ln));
            const int row = F.wave * 32 + (ln & 31), half = ln >> 5; unsigned bits;
            if (own <= 3) bits = (1u << own) - 1u;
            else { const bf16* qp = QKV + 3 * QKV_STRIDE + ((size_t)b * SEQ + own * 256 + row) * BW + h * HD + 64 * half; const float* km = KMEAN + (size_t)bh * 8 * HD + 64 * half; float gt[7];
#pragma unroll
                for (int n = 0; n < 7; ++n) gt[n] = 0.f;
#pragma unroll 2
                for (int c8 = 0; c8 < 8; ++c8) { const u32x4 qw = *(const u32x4*)(qp + 8 * c8); const float q0 = bflo(qw.x), q1 = bfhi(qw.x), q2 = bflo(qw.y), q3 = bfhi(qw.y), q4 = bflo(qw.z), q5 = bfhi(qw.z), q6 = bflo(qw.w), q7 = bfhi(qw.w);
#pragma unroll
                    for (int n = 0; n < 7; ++n) { const f32x4 ka = *(const f32x4*)(km + n * HD + 8 * c8), kb = *(const f32x4*)(km + n * HD + 8 * c8 + 4);
                        gt[n] += (q0 * ka[0] + q1 * ka[1]) + (q2 * ka[2] + q3 * ka[3]) + (q4 * kb[0] + q5 * kb[1]) + (q6 * kb[2] + q7 * kb[3]); } }
#pragma unroll
                for (int n = 0; n < 7; ++n) gt[n] += __shfl_xor(gt[n], 32);
                bits = 0u;
#pragma unroll
                for (int n = 0; n < 7; ++n) { int rank = 0;
#pragma unroll
                    for (int m = 0; m < 7; ++m) { const bool valid = m < own; const bool better = (gt[m] > gt[n]) || (gt[m] == gt[n] && m < n); rank += (valid && m != n && better) ? 1 : 0; }
                    if (n < own && rank < 3) bits |= 1u << n; } }
            if (half == 0) SELB[(size_t)bh * SEQ + own * 256 + row] = bits;
            VM_WAIT(); };
        auto is_moba = [](int id) -> bool { return (((id & 255) >> 3) >> 4) != 0; };
        auto fetch = [&]() -> int {
            unsigned qo = F.MISC[16];
            while (qo < 8u) { const unsigned q = ((unsigned)cls + qo) & 7u; const unsigned idx = atomicAdd(F.ctl + CW_ATTQ + 64 * q, 1u); if (idx < 256u) { F.MISC[16] = qo; return (int)(q * 256u + idx); } ++qo; }
            F.MISC[16] = 8u; return -1; };
        const bool fetcher = F.wave == 0 && lane_now() == 0;
        if (fetcher) { F.MISC[16] = 0u; const int a0 = fetch(); const int a1 = a0 >= 0 ? fetch() : -1; F.MISC[12] = (unsigned)a0; F.MISC[13] = (unsigned)a1; }
        __syncthreads();
        int cur_id = __builtin_amdgcn_readfirstlane((int)F.MISC[12]), nxt_id = __builtin_amdgcn_readfirstlane((int)F.MISC[13]);
        __syncthreads();
        if (cur_id >= 0) {
            att::BlockRef cur = mkref(cur_id); att::Seam S; int iter = 0;
            if (is_moba(cur_id)) moba_select(cur_id);
            att::attn_prime(cur, alds, S, F.wave);
            for (;;) {
                const bool last = nxt_id < 0;
                const att::BlockRef nxt = last ? cur : mkref(nxt_id);
                if (!last && fetcher) F.MISC[12 + (iter & 1)] = (unsigned)fetch();
                __builtin_amdgcn_sched_barrier(0); if (!last && is_moba(nxt_id)) moba_select(nxt_id); __builtin_amdgcn_sched_barrier(0);
                att::attn_block(cur, nxt, alds, S, F.wave);
                if (last) break;
                cur = nxt; nxt_id = __builtin_amdgcn_readfirstlane((int)F.MISC[12 + (iter & 1)]); ++iter;
            }
        }
    }
        if (BOTH(4)) GRID_BAR();
    }

    if (IN(5)) {
    _Pragma("unroll") for (int rep_ = 0; rep_ <= REP(5); ++rep_) {
        { pg8::Gemm g{DM, DM, DM}; pg8::DenseOrder S; S.init(Ob, Wt_cat, DM, DM, T, DM, F.G, (int)blockIdx.x, 1); S.rep = 1 + REP(20); pg8::EpiGate E{SG, MIX8};
          pg8::gemm_phase<pg8::EpiGate, pg8::DenseOrder, true, false, true>(F.lds, g, S, E, F.wave); }
    if (REP(5) && rep_ == 0) { VM_WAIT(); __syncthreads(); } }
        if (BOTH(5)) GRID_BAR();
    }

    if (IN(6)) {
    _Pragma("unroll") for (int rep_ = 0; rep_ <= REP(6); ++rep_) {
        pg8::Gemm g{DM, DM, DM}; pg8::DenseOrder S; S.init(MIX8, Wt_out, DM, DM, T, DM, F.G, (int)blockIdx.x, 1); S.rep = 1 + REP(21); pg8::EpiResid E{x, X2, HN8, g_ffn};
        pg8::gemm_phase<pg8::EpiResid, pg8::DenseOrder, true, false, true>(F.lds, g, S, E, F.wave);
    if (REP(6) && rep_ == 0) { VM_WAIT(); __syncthreads(); } }
        if (BOTH(6)) GRID_BAR();
    }

    if (IN(7)) {
        const int lane7 = (int)__builtin_amdgcn_mbcnt_hi(~0u, __builtin_amdgcn_mbcnt_lo(~0u, 0u));
        LAS int* lcnt = (LAS int*)(F.lds + TAB_OFF); LAS int* lbase = lcnt + 32;
        for (int wt0 = F.vcu * NWAVES; wt0 < T / 16; wt0 += F.NGW) {
            const int tid7 = F.wave * 64 + lane7;
            if (tid7 < 32) lcnt[tid7] = 0;
            __syncthreads();
            const int row0 = (wt0 + F.wave) * 16, j = lane7 & 15, q = lane7 >> 4;
            const bf16* xrow = X2 + (size_t)(row0 + j) * DM + 8 * q;
            f32x4 acc0 = {0.f, 0.f, 0.f, 0.f}, acc1 = acc0; float ss = 0.f;
#pragma unroll 1
            for (int half = 0; half < 2; ++half) {
                if (half) __syncthreads();
                { const f32x4* src = (const f32x4*)(WR + half * 32768); f32x4 tmp[16];
#pragma unroll
                  for (int u = 0; u < 16; ++u) tmp[u] = src[tid7 + 512 * u];
#pragma unroll
                  for (int u = 0; u < 16; ++u) { const int i = tid7 + 512 * u, cc = i >> 8, ln = (i >> 2) & 63, k4 = i & 3; ((LAS f32x4*)F.lds)[cc * 256 + k4 * 64 + ln] = tmp[u]; } }
                __syncthreads();
                const LAS f32x4* wl = (const LAS f32x4*)F.lds + lane7;
#pragma unroll 4
                for (int c = 0; c < 32; ++c) { const u32x4 xw = *(const u32x4*)(xrow + 32 * (half * 32 + c)); const f32x4 wa = wl[c * 256], wb = wl[c * 256 + 64], wc2 = wl[c * 256 + 128], wd = wl[c * 256 + 192];
                    const float xv[8] = {bflo(xw.x), bfhi(xw.x), bflo(xw.y), bfhi(xw.y), bflo(xw.z), bfhi(xw.z), bflo(xw.w), bfhi(xw.w)};
#pragma unroll
                    for (int s = 0; s < 8; ++s) { ss += xv[s] * xv[s]; acc0 = __builtin_amdgcn_mfma_f32_16x16x4f32(s < 4 ? wa[s] : wb[s - 4], xv[s], acc0, 0, 0, 0); acc1 = __builtin_amdgcn_mfma_f32_16x16x4f32(s < 4 ? wc2[s] : wd[s - 4], xv[s], acc1, 0, 0, 0); } } }
            ss += __shfl_xor(ss, 16); ss += __shfl_xor(ss, 32);
            const float rstd = 1.0f / sqrtf(ss * (1.0f / DM) + RMS_EPS);
            float lg[8]; const f32x4 br0 = *(const f32x4*)(b_router + 4 * q), br1 = *(const f32x4*)(b_router + 16 + 4 * q);
#pragma unroll
            for (int r = 0; r < 4; ++r) { lg[r] = acc0[r] * rstd + br0[r]; lg[4 + r] = acc1[r] * rstd + br1[r]; }
            float tv[4]; int ti[4];
#pragma unroll
            for (int k = 0; k < TOPK; ++k) { float bv = lg[0]; int bi = 4 * q;
#pragma unroll
                for (int r = 1; r < 8; ++r) { const int e = (r < 4) ? 4 * q + r : 16 + 4 * q + (r - 4); if (lg[r] > bv) { bv = lg[r]; bi = e; } }
#pragma unroll
                for (int off = 16; off <= 32; off <<= 1) { const float ov = __shfl_xor(bv, off); const int oi = __shfl_xor(bi, off); if (ov > bv || (ov == bv && oi < bi)) { bv = ov; bi = oi; } }
                tv[k] = bv; ti[k] = bi;
#pragma unroll
                for (int r = 0; r < 8; ++r) { const int e = (r < 4) ? 4 * q + r : 16 + 4 * q + (r - 4); if (e == bi) lg[r] = -__builtin_inff(); } }
            const float e1 = expf(tv[1] - tv[0]), e2 = expf(tv[2] - tv[0]), e3 = expf(tv[3] - tv[0]), inv = 1.0f / (1.0f + e1 + e2 + e3);
            const float gwt[4] = {inv, e1 * inv, e2 * inv, e3 * inv};
            int lr[4] = {0, 0, 0, 0};
            if (q == 0) {
#pragma unroll
                for (int k = 0; k < TOPK; ++k) lr[k] = __hip_atomic_fetch_add(lcnt + ti[k], 1, __ATOMIC_RELAXED, __HIP_MEMORY_SCOPE_WORKGROUP); }
            __syncthreads();
            if (tid7 < 32) lbase[tid7] = (int)__hip_atomic_fetch_add(F.ctl + CW_CNT + 64 * tid7, (unsigned)lcnt[tid7], RLX_AGENT);
            __syncthreads();
            if (q == 0) { const int t = row0 + j;
#pragma unroll
                for (int k = 0; k < TOPK; ++k) { const int rk = lbase[ti[k]] + lr[k], pe = ti[k] * CAPE + rk; EIDX[t * 4 + k] = ti[k]; RANK[t * 4 + k] = rk; ROWTOK[pe] = t; ROWWE[pe] = gwt[k]; ROWRSTD[pe] = rstd; } }
            __syncthreads();
        }
        if (BOTH(7)) GRID_BAR();
    }

    LAS int* tab = (LAS int*)(F.lds + TAB_OFF + 512);
    if (hi > 8) {
        if (F.wave == 0 && lane_now() == 0) { int acc = 0; for (int e = 0; e < NE; ++e) { tab[e] = acc; const unsigned c = __hip_atomic_load(F.ctl + CW_CNT + 64 * e, RLX_AGENT); acc += (int)((c + 255u) >> 8); } tab[NE] = acc; }
        __syncthreads();
    }


    if (IN(9)) {
    _Pragma("unroll") for (int rep_ = 0; rep_ <= REP(9); ++rep_) {
        pg8::Gemm g{DM, DM, DM}; pg8::MoeOrder<16, true> S{HN8, Wt_1, DM, DM, tab, F.G, (int)blockIdx.x, 1 + REP(18), ROWTOK}; pg8::EpiSwiglu E{ACT, b_mlp1, ROWRSTD};
        pg8::gemm_phase<pg8::EpiSwiglu, pg8::MoeOrder<16, true>, true, false, true>(F.lds, g, S, E, F.wave);
    if (REP(9) && rep_ == 0) { VM_WAIT(); __syncthreads(); } }
        if (BOTH(9)) GRID_BAR();
    }

    if (IN(10)) {
    _Pragma("unroll") for (int rep_ = 0; rep_ <= REP(10); ++rep_) {
        pg8::Gemm g{DFF, DFF, DFF}; pg8::MoeOrder<8> S{ACT, Wt_2, DFF, DFF, tab, F.G, (int)blockIdx.x, 1 + REP(19)}; pg8::EpiDown E{Yb, b_mlp2, ROWWE};
        pg8::gemm_phase<pg8::EpiDown, pg8::MoeOrder<8>, true, false, true>(F.lds, g, S, E, F.wave);
    if (REP(10) && rep_ == 0) { VM_WAIT(); __syncthreads(); } }
        if (BOTH(10)) GRID_BAR();
    }

    if (IN(11)) {
    _Pragma("unroll") for (int rep_ = 0; rep_ <= REP(11); ++rep_) {
        const bool poison = xb_ld(F.ctl + CW_BAR + XB_TMO) != 0u;
        const int lane11 = (int)__builtin_amdgcn_mbcnt_hi(~0u, __builtin_amdgcn_mbcnt_lo(~0u, 0u));
        int posn[4]; u32x2 xn[8];
        { const int t0 = F.gw;
#pragma unroll
          for (int k = 0; k < 4; ++k) posn[k] = tab[EIDX[t0 * 4 + k]] * 256 + RANK[t0 * 4 + k];
          const u32x2* xr0 = (const u32x2*)(X2 + (size_t)t0 * DM) + lane11;
#pragma unroll
          for (int j = 0; j < 8; ++j) xn[j] = xr0[64 * j]; }
        for (int t = F.gw; t < T; t += F.NGW) {
            int pos[4]; u32x2 xc[8];
#pragma unroll
            for (int k = 0; k < 4; ++k) pos[k] = posn[k];
#pragma unroll
            for (int j = 0; j < 8; ++j) xc[j] = xn[j];
            unsigned yv[8][4];
#pragma unroll
            for (int j = 0; j < 8; ++j)
#pragma unroll
                for (int k = 0; k < 4; ++k) yv[j][k] = *((const unsigned*)(Yb + (size_t)pos[k] * DM) + lane11 + 64 * j);
            if (t + F.NGW < T) { const int t1 = t + F.NGW;
#pragma unroll
                for (int k = 0; k < 4; ++k) posn[k] = tab[EIDX[t1 * 4 + k]] * 256 + RANK[t1 * 4 + k];
                const u32x2* xr1 = (const u32x2*)(X2 + (size_t)t1 * DM) + lane11;
#pragma unroll
                for (int j = 0; j < 8; ++j) xn[j] = xr1[64 * j]; }
            f32x4 v[8]; float ss = 0.f;
#pragma unroll
            for (int j = 0; j < 8; ++j) { v[j] = (f32x4){bflo(xc[j].x), bfhi(xc[j].x), bflo(xc[j].y), bfhi(xc[j].y)};
#pragma unroll
                for (int k = 0; k < 4; ++k) { const unsigned y = yv[j][k]; const f32x2 ylo = __builtin_amdgcn_cvt_pk_f32_fp8(y, false), yhi = __builtin_amdgcn_cvt_pk_f32_fp8(y, true);
                    v[j][0] += ylo[0] * (1.0f / Y8_SCALE); v[j][1] += ylo[1] * (1.0f / Y8_SCALE); v[j][2] += yhi[0] * (1.0f / Y8_SCALE); v[j][3] += yhi[1] * (1.0f / Y8_SCALE); }
                ss += (v[j][0] * v[j][0] + v[j][1] * v[j][1]) + (v[j][2] * v[j][2] + v[j][3] * v[j][3]); }
            float rstd = 1.0f / sqrtf(wave_sum(ss) * (1.0f / DM) + RMS_EPS); if (poison) rstd = __builtin_nanf("");
            f32x4* orow = (f32x4*)(args.out + (size_t)t * DM) + lane11;
#pragma unroll
            for (int j = 0; j < 8; ++j) { const f32x4 g = *((const f32x4*)g_final + lane11 + 64 * j); orow[64 * j] = v[j] * rstd * g; }
        }
    }
    }
#undef IN
#undef BOTH
#undef GRID_BAR
}

constexpr int N_PHASES = 12;
extern "C" void kernel_launch(void* const* d_in, const int* in_sizes, int n_in, void* d_out, int out_size, void* d_ws, size_t ws_size, hipStream_t stream) {
    static int grid = 0;
    if (grid == 0) {
        if (n_in != 15 || in_sizes[0] != T * DM || out_size != T * DM || ws_size < WS_END) { fprintf(stderr, "kernel_launch: unexpected shapes (n_in %d, in0 %d, out %d, ws %zu < %zu); nothing launched\n", n_in, n_in > 0 ? in_sizes[0] : -1, out_size, ws_size, (size_t)WS_END); grid = -1; return; }
        int dev = 0, cus = 0, per_cu = 0;
        if (hipGetDevice(&dev) != hipSuccess || hipDeviceGetAttribute(&cus, hipDeviceAttributeMultiprocessorCount, dev) != hipSuccess) { fprintf(stderr, "kernel_launch: device query failed\n"); grid = -1; return; }
        if (hipFuncSetAttribute((const void*)fwd_kernel, hipFuncAttributeMaxDynamicSharedMemorySize, LDS_BYTES) != hipSuccess) { fprintf(stderr, "kernel_launch: hipFuncSetAttribute failed\n"); grid = -1; return; }
        if (hipOccupancyMaxActiveBlocksPerMultiprocessor(&per_cu, (const void*)fwd_kernel, NWAVES * 64, LDS_BYTES) != hipSuccess || per_cu < 1)
            fprintf(stderr, "kernel_launch: note: occupancy query reports %d workgroups per CU\n", per_cu);
        (void)hipGetLastError();
        grid = cus;
    }
    if (grid < 0) return;
    if (hipMemsetAsync((char*)d_ws + WS_CTL, 0, CTL_ZERO_BYTES, stream) != hipSuccess) { fprintf(stderr, "kernel_launch: memset failed\n"); return; }
    Args a{};
    for (int i = 0; i < 15; ++i) a.in[i] = (const float*)d_in[i];
    a.out = (float*)d_out; a.ws = (unsigned char*)d_ws;
#if MK_PER_PHASE
    for (int p = 0; p < N_PHASES; ++p) { a.ph_lo = p; a.ph_hi = p + 1; hipLaunchKernelGGL(fwd_kernel, dim3(grid), dim3(NWAVES * 64), LDS_BYTES, stream, a); }
#else
    a.ph_lo = 0; a.ph_hi = N_PHASES;
    hipLaunchKernelGGL(fwd_kernel, dim3(grid), dim3(NWAVES * 64), LDS_BYTES, stream, a);
#endif
    const hipError_t le = hipPeekAtLastError();
    if (le != hipSuccess) fprintf(stderr, "kernel_launch: launch failed: %s\n", hipGetErrorName(le));
}
```
